# Optimizing an MI355X kernel written in HIP

```python
import math
import jax, jax.numpy as jnp
from jax import lax
import numpy as np

D_MODEL = 1024
BATCH = 8
SEQ = 4096
DEPTH = 4

N_A_LAYERS = DEPTH // 2
N_B_LAYERS = DEPTH - N_A_LAYERS

HEAD_DIM = 64
SB_HEADS = D_MODEL // HEAD_DIM
SWA_Q_HEADS = D_MODEL // HEAD_DIM
SWA_KV_HEADS = SWA_Q_HEADS // 8
SWA_GROUP = SWA_Q_HEADS // SWA_KV_HEADS
WINDOW = 128
BLOCK = 128
D_FF = 4 * D_MODEL
NUM_BUCKETS = 32
MAX_EXACT = NUM_BUCKETS // 2
MAX_DISTANCE = 128
EPS = 1e-5
NEG_INF = -1e30

kernel_name = "yoco_stickbreaking_swa_sinks_trunk"


def rmsnorm(x, g):
    xf = x.astype(jnp.float32)
    y = xf * lax.rsqrt(jnp.mean(xf * xf, axis=-1, keepdims=True) + EPS)
    return (y * g.astype(jnp.float32)).astype(x.dtype)


def sq_relu_mlp(x, w_up, w_down):
    u = jax.nn.relu(x @ w_up)
    return (u * u) @ w_down


def stick_breaking_attention(x, w_qkv, w_o):
    b, s_len, _ = x.shape
    nb = s_len // BLOCK
    scale = 1.0 / math.sqrt(HEAD_DIM)
    q, k, v = jnp.split(x @ w_qkv, 3, axis=-1)
    q = q.reshape(b, nb, BLOCK, SB_HEADS, HEAD_DIM).transpose(1, 0, 3, 2, 4)
    k = k.reshape(b, s_len, SB_HEADS, HEAD_DIM).transpose(0, 2, 1, 3)
    v = v.reshape(b, s_len, SB_HEADS, HEAD_DIM).transpose(0, 2, 1, 3)
    key_pos = jnp.arange(s_len)

    def one_block(args):
        q_blk, blk = args
        z = jnp.einsum('bhqd,bhkd->bhqk', q_blk, k, preferred_element_type=jnp.float32) * scale
        q_pos = blk * BLOCK + jnp.arange(BLOCK)
        causal = key_pos[None, :] < q_pos[:, None]
        log_1m = jnp.where(causal, jax.nn.log_sigmoid(-z), 0.0)
        after = lax.cumsum(log_1m, axis=3, reverse=True) - log_1m
        w = jnp.where(causal, jnp.exp(jax.nn.log_sigmoid(z) + after), 0.0)
        return jnp.einsum('bhqk,bhkd->bhqd', w.astype(v.dtype), v)

    o = lax.map(one_block, (q, jnp.arange(nb)))
    o = o.transpose(1, 0, 3, 2, 4).reshape(b, s_len, SB_HEADS * HEAD_DIM)
    return o @ w_o


def t5_bucket(n):
    nf = jnp.maximum(n, 1).astype(jnp.float32)
    large = MAX_EXACT + (jnp.log(nf / MAX_EXACT) / math.log(MAX_DISTANCE / MAX_EXACT)
                         * (NUM_BUCKETS - MAX_EXACT)).astype(jnp.int32)
    large = jnp.minimum(large, NUM_BUCKETS - 1)
    return jnp.where(n < MAX_EXACT, n, large)


def band_distance():
    qi = jnp.arange(BLOCK)[:, None]
    kj = jnp.arange(2 * BLOCK)[None, :]
    return qi + BLOCK - kj


def relative_bias_band(rel_bias):
    bucket = t5_bucket(jnp.maximum(band_distance(), 0))
    bias = rel_bias.astype(jnp.float32)[bucket]
    return bias.transpose(2, 0, 1).reshape(SWA_KV_HEADS, SWA_GROUP, BLOCK, 2 * BLOCK)


def band_valid(nb):
    dist = band_distance()
    key_pos = jnp.arange(nb)[:, None, None] * BLOCK - BLOCK + jnp.arange(2 * BLOCK)[None, None, :]
    return (dist >= 0) & (dist < WINDOW) & (key_pos >= 0)


def to_band(t):
    b, s_len, g, dh = t.shape
    nb = s_len // BLOCK
    prev = jnp.pad(t, ((0, 0), (BLOCK, 0), (0, 0), (0, 0)))[:, :s_len].reshape(b, nb, BLOCK, g, dh)
    cur = t.reshape(b, nb, BLOCK, g, dh)
    return jnp.concatenate([prev, cur], axis=2)


def shared_kv(h, kv_norm, w_kv, b_kv):
    b, s_len, _ = h.shape
    kv = rmsnorm(h, kv_norm) @ w_kv + b_kv
    k, v = jnp.split(kv, 2, axis=-1)
    k = k.reshape(b, s_len, SWA_KV_HEADS, HEAD_DIM)
    v = v.reshape(b, s_len, SWA_KV_HEADS, HEAD_DIM)
    return to_band(k), to_band(v)


def swa_sink_attention(x, k_band, v_band, w_q, b_q, sinks, w_o, b_o, bias_band, valid):
    b, s_len, _ = x.shape
    nb = s_len // BLOCK
    scale = 1.0 / math.sqrt(HEAD_DIM)
    q = (x @ w_q + b_q).reshape(b, nb, BLOCK, SWA_KV_HEADS, SWA_GROUP, HEAD_DIM)
    s = jnp.einsum('bnqgrd,bnkgd->bngrqk', q, k_band, preferred_element_type=jnp.float32) * scale
    s = s + bias_band[None, None]
    s = jnp.where(valid[None, :, None, None], s, NEG_INF)
    sink = jnp.broadcast_to(sinks.astype(jnp.float32).reshape(SWA_KV_HEADS, SWA_GROUP, 1, 1),
                            s.shape[:-1] + (1,))
    p = jax.nn.softmax(jnp.concatenate([s, sink], axis=-1), axis=-1)[..., :-1]
    o = jnp.einsum('bngrqk,bnkgd->bnqgrd', p.astype(v_band.dtype), v_band)
    return o.reshape(b, s_len, SWA_Q_HEADS * HEAD_DIM) @ w_o + b_o


def setup_inputs(seed: int = 0) -> dict:
    key = jax.random.key(seed)
    ks = jax.random.split(key, 20)
    f32 = jnp.float32

    def nrm(k, shape, fan_in):
        return jax.random.normal(k, shape, f32) * fan_in ** -0.5

    def gain(k, shape):
        return 1.0 + 0.02 * jax.random.normal(k, shape, f32)

    kv_width = 2 * SWA_KV_HEADS * HEAD_DIM
    return {
        "x": jax.random.normal(ks[0], (BATCH, SEQ, D_MODEL), f32),
        "a_norm": gain(ks[1], (N_A_LAYERS, D_MODEL)),
        "a_wqkv": nrm(ks[2], (N_A_LAYERS, D_MODEL, 3 * SB_HEADS * HEAD_DIM), D_MODEL),
        "a_wo": nrm(ks[3], (N_A_LAYERS, SB_HEADS * HEAD_DIM, D_MODEL), SB_HEADS * HEAD_DIM),
        "kv_norm": gain(ks[4], (D_MODEL,)),
        "w_kv": nrm(ks[5], (D_MODEL, kv_width), D_MODEL),
        "b_kv": 0.02 * jax.random.normal(ks[6], (kv_width,), f32),
        "b_norm": gain(ks[7], (N_B_LAYERS, D_MODEL)),
        "b_wq": nrm(ks[8], (N_B_LAYERS, D_MODEL, SWA_Q_HEADS * HEAD_DIM), D_MODEL),
        "b_bq": 0.02 * jax.random.normal(ks[9], (N_B_LAYERS, SWA_Q_HEADS * HEAD_DIM), f32),
        "b_sinks": 0.5 * jax.random.normal(ks[10], (N_B_LAYERS, SWA_Q_HEADS), f32),
        "b_wo": nrm(ks[11], (N_B_LAYERS, SWA_Q_HEADS * HEAD_DIM, D_MODEL), SWA_Q_HEADS * HEAD_DIM),
        "b_bo": 0.02 * jax.random.normal(ks[12], (N_B_LAYERS, D_MODEL), f32),
        "rel_bias": 0.5 * jax.random.normal(ks[13], (NUM_BUCKETS, SWA_Q_HEADS), f32),
        "mlp_norm": gain(ks[14], (DEPTH, D_MODEL)),
        "mlp_up": nrm(ks[15], (DEPTH, D_MODEL, D_FF), D_MODEL),
        "mlp_down": nrm(ks[16], (DEPTH, D_FF, D_MODEL), D_FF),
        "final_norm": gain(ks[17], (D_MODEL,)),
    }


def reference(x, a_norm, a_wqkv, a_wo, kv_norm, w_kv, b_kv, b_norm, b_wq, b_bq, b_sinks,
              b_wo, b_bo, rel_bias, mlp_norm, mlp_up, mlp_down, final_norm):
    nb = x.shape[1] // BLOCK
    bias_band = relative_bias_band(rel_bias)
    valid = band_valid(nb)
    h = x
    k_band = v_band = None
    for layer in range(DEPTH):
        if layer < N_A_LAYERS:
            h = h + stick_breaking_attention(rmsnorm(h, a_norm[layer]), a_wqkv[layer], a_wo[layer])
        else:
            j = layer - N_A_LAYERS
            if j == 0:
                k_band, v_band = shared_kv(h, kv_norm, w_kv, b_kv)
            h = h + swa_sink_attention(rmsnorm(h, b_norm[j]), k_band, v_band, b_wq[j], b_bq[j],
                                       b_sinks[j], b_wo[j], b_bo[j], bias_band, valid)
        h = h + sq_relu_mlp(rmsnorm(h, mlp_norm[layer]), mlp_up[layer], mlp_down[layer])
    return rmsnorm(h, final_norm)
```

```cpp
#include <hip/hip_runtime.h>
#include <hip/hip_cooperative_groups.h>
#include <cstdio>
#include <cstdint>
namespace cg = cooperative_groups;
namespace pg8 {
#define PG8_LAS __attribute__((address_space(3)))
typedef unsigned short bf16_t;
typedef short bf16x8 __attribute__((ext_vector_type(8)));
typedef float f32x4 __attribute__((ext_vector_type(4)));
typedef unsigned u32x4 __attribute__((ext_vector_type(4)));
constexpr int BM = 256, BK = 64, HALF = 128, HTB = HALF * BK * 2  , STAGE_BYTES = 8 * HTB, NXCD = 8, WGM = 8;

__host__ __device__ __forceinline__ int lds_byte(int r, int c) { const int st = (r >> 4) * 2 + (c >> 5), rr = r & 15, cc = c & 31, ob = rr * 64 + cc * 2; return st * 1024 + (ob ^ (((ob >> 9) & 1) << 5)); }
__host__ __device__ __forceinline__ void stage_rc(int b, int& R, int& C) { const int st = b / 1024, sb = b % 1024, swz = sb ^ (((sb >> 9) & 1) << 5); R = (st >> 1) * 16 + swz / 64; C = (st & 1) * 32 + (swz % 64) / 2; }
__host__ __device__ __forceinline__ int perm32(int rho) { const int n = rho >> 4, i = rho & 15; return 8 * (i >> 2) + 4 * n + (i & 3); }

struct Unit { int pm, pn; };
struct Gemm { const bf16_t* A; const bf16_t* Bt; int M, N, K; };

struct StaticOrder {
    int nM, nN, nwg, G, c;
    __host__ __device__ void init(int M, int N, int G_, int c_) { nM = M / BM; nN = N / BM; nwg = nM * nN; G = G_; c = c_; }
    __host__ __device__ bool next(int i, Unit& u) const {
        const long L = (long)i * G + c; if (L >= nwg) return false;
        int wgid = (int)L; { const int q = nwg / NXCD, r = nwg % NXCD, xcd = wgid % NXCD, off = wgid / NXCD; wgid = (xcd < r ? xcd * (q + 1) : r * (q + 1) + (xcd - r) * q) + off; }
        const int nig = WGM * nN, gid = wgid / nig, fm = gid * WGM, gsz = (nM - fm) < WGM ? (nM - fm) : WGM;
        u.pm = fm + ((wgid % nig) % gsz); u.pn = (wgid % nig) / gsz; return true;
    }
    __device__ __forceinline__ void a_ready(const Unit&) const {}
    __device__ __forceinline__ void done(const Unit&) const {}
};

__device__ __forceinline__ unsigned cvt_pk_bf16(float lo, float hi) { unsigned r; asm volatile("v_cvt_pk_bf16_f32 %0, %1, %2" : "=v"(r) : "v"(lo), "v"(hi)); return r; }
typedef float f32x2 __attribute__((ext_vector_type(2)));
typedef unsigned u32x2 __attribute__((ext_vector_type(2)));
constexpr float RMS_EPS = 1e-5f;
constexpr int DM = 1024, SEQ = 4096, FF = 4096;
__device__ __forceinline__ float rstd_of(float ssq) { return 1.0f / sqrtf(ssq * (1.0f / 1024.0f) + RMS_EPS); }
__device__ __forceinline__ unsigned short bf1(float v) { return (unsigned short)(cvt_pk_bf16(v, 0.f) & 0xffffu); }

struct EpiQKV {
    static constexpr bool PERM = true, AFTER_DRAIN = false;
    bf16_t* Q; bf16_t* K; bf16_t* VT; const float* ssq;
    __device__ __forceinline__ void operator()(const f32x4 (&acc)[2][2][4][2], const Unit& u, int wr, int wc, int fr, int fq) const {
        const int row0 = u.pm * BM + wr * 64 + fr;
        const int t = u.pn >> 2, col0 = (u.pn & 3) * BM + wc * 32 + 8 * fq;
        if (t < 2) {
            bf16_t* base = t == 0 ? Q : K;
#pragma unroll
            for (int ai = 0; ai < 2; ++ai)
#pragma unroll
                for (int m = 0; m < 4; ++m) { const int row = row0 + ai * HALF + m * 16; const float rs = rstd_of(ssq[row]); bf16_t* rowp = base + (size_t)row * DM + col0;
#pragma unroll
                    for (int bj = 0; bj < 2; ++bj) { const f32x4 v0 = acc[ai][bj][m][0] * rs, v1 = acc[ai][bj][m][1] * rs; u32x4 w;
                        w.x = cvt_pk_bf16(v0[0], v0[1]); w.y = cvt_pk_bf16(v0[2], v0[3]); w.z = cvt_pk_bf16(v1[0], v1[1]); w.w = cvt_pk_bf16(v1[2], v1[3]);
                        *(u32x4*)(rowp + bj * HALF) = w; } }
        } else {
#pragma unroll
            for (int ai = 0; ai < 2; ++ai)
#pragma unroll
                for (int m = 0; m < 4; ++m) { asm volatile("" ::: "memory"); const int row = row0 + ai * HALF + m * 16; const float rs = rstd_of(ssq[row]); const int b = row >> 12, s = row & 4095;
                    bf16_t* cp = VT + ((size_t)(b * DM + col0)) * SEQ + s;
#pragma unroll
                    for (int bj = 0; bj < 2; ++bj)
#pragma unroll
                        for (int n = 0; n < 2; ++n)
#pragma unroll
                            for (int j = 0; j < 4; ++j) cp[(size_t)(bj * HALF + 4 * n + j) * SEQ] = bf1(acc[ai][bj][m][n][j] * rs); }
        }
    }
};

template <bool HAS_KV> struct EpiQB {
    static constexpr bool PERM = true, AFTER_DRAIN = false;
    bf16_t* Q; bf16_t* Ksh; bf16_t* VTsh; const float* bq; const float* bkv; const float* ssq;
    __device__ __forceinline__ void operator()(const f32x4 (&acc)[2][2][4][2], const Unit& u, int wr, int wc, int fr, int fq) const {
        const int row0 = u.pm * BM + wr * 64 + fr;
        if (!HAS_KV || u.pn < 4) {
            const int col0 = u.pn * BM + wc * 32 + 8 * fq;
#pragma unroll
            for (int ai = 0; ai < 2; ++ai)
#pragma unroll
                for (int m = 0; m < 4; ++m) { const int row = row0 + ai * HALF + m * 16; const float rs = rstd_of(ssq[row]); bf16_t* rowp = Q + (size_t)row * DM + col0;
#pragma unroll
                    for (int bj = 0; bj < 2; ++bj) { const f32x4 b0 = *(const f32x4*)(bq + col0 + bj * HALF), b1 = *(const f32x4*)(bq + col0 + bj * HALF + 4);
                        const f32x4 v0 = acc[ai][bj][m][0] * rs + b0, v1 = acc[ai][bj][m][1] * rs + b1; u32x4 w;
                        w.x = cvt_pk_bf16(v0[0], v0[1]); w.y = cvt_pk_bf16(v0[2], v0[3]); w.z = cvt_pk_bf16(v1[0], v1[1]); w.w = cvt_pk_bf16(v1[2], v1[3]);
                        *(u32x4*)(rowp + bj * HALF) = w; }
                    asm volatile("" ::: "memory"); }
        } else {
            const int c0 = wc * 32 + 8 * fq;
#pragma unroll
            for (int ai = 0; ai < 2; ++ai)
#pragma unroll
                for (int m = 0; m < 4; ++m) { const int row = row0 + ai * HALF + m * 16; const float rs = rstd_of(ssq[row]); const int b = row >> 12, s = row & 4095;
                    { const f32x4 b0 = *(const f32x4*)(bkv + c0), b1 = *(const f32x4*)(bkv + c0 + 4);
                      const f32x4 v0 = acc[ai][0][m][0] * rs + b0, v1 = acc[ai][0][m][1] * rs + b1; u32x4 w;
                      w.x = cvt_pk_bf16(v0[0], v0[1]); w.y = cvt_pk_bf16(v0[2], v0[3]); w.z = cvt_pk_bf16(v1[0], v1[1]); w.w = cvt_pk_bf16(v1[2], v1[3]);
                      *(u32x4*)(Ksh + (size_t)row * 128 + c0) = w; }
                    bf16_t* cp = VTsh + ((size_t)(b * 128 + c0)) * SEQ + s;
#pragma unroll
                    for (int n = 0; n < 2; ++n) { const f32x4 bb = *(const f32x4*)(bkv + 128 + c0 + 4 * n);
#pragma unroll
                        for (int j = 0; j < 4; ++j) cp[(size_t)(4 * n + j) * SEQ] = bf1(acc[ai][1][m][n][j] * rs + bb[j]); }
                    asm volatile("" ::: "memory"); }
        }
    }
};

struct EpiUp {
    static constexpr bool PERM = true, AFTER_DRAIN = false;
    bf16_t* U; const float* ssq;
    __device__ __forceinline__ void operator()(const f32x4 (&acc)[2][2][4][2], const Unit& u, int wr, int wc, int fr, int fq) const {
        const int row0 = u.pm * BM + wr * 64 + fr, col0 = u.pn * BM + wc * 32 + 8 * fq;
#pragma unroll
        for (int ai = 0; ai < 2; ++ai)
#pragma unroll
            for (int m = 0; m < 4; ++m) { const int row = row0 + ai * HALF + m * 16; const float rs = rstd_of(ssq[row]); bf16_t* rowp = U + (size_t)row * FF + col0;
#pragma unroll
                for (int bj = 0; bj < 2; ++bj) { f32x4 v0 = acc[ai][bj][m][0] * rs, v1 = acc[ai][bj][m][1] * rs;
#pragma unroll
                    for (int j = 0; j < 4; ++j) { const float a = fmaxf(v0[j], 0.f), b = fmaxf(v1[j], 0.f); v0[j] = a * a; v1[j] = b * b; }
                    u32x4 w; w.x = cvt_pk_bf16(v0[0], v0[1]); w.y = cvt_pk_bf16(v0[2], v0[3]); w.z = cvt_pk_bf16(v1[0], v1[1]); w.w = cvt_pk_bf16(v1[2], v1[3]);
                    *(u32x4*)(rowp + bj * HALF) = w; } }
    }
};

struct EpiResid {
    static constexpr bool PERM = false, AFTER_DRAIN = false;
    const float* base; float* out; bf16_t* hb; const float* bias; float* ssq_out;
    __device__ __forceinline__ void operator()(const f32x4 (&acc)[2][2][4][2], const Unit& u, int wr, int wc, int fr, int fq) const {
        const int row0 = u.pm * BM + wr * 64 + fr, col0 = u.pn * BM + wc * 32 + 4 * fq;
        f32x4 bv[2][2];
#pragma unroll
        for (int bj = 0; bj < 2; ++bj)
#pragma unroll
            for (int n = 0; n < 2; ++n) bv[bj][n] = bias ? *(const f32x4*)(bias + col0 + bj * HALF + n * 16) : (f32x4){0.f, 0.f, 0.f, 0.f};
#pragma unroll
        for (int ai = 0; ai < 2; ++ai)
#pragma unroll
            for (int m = 0; m < 4; ++m) { const int row = row0 + ai * HALF + m * 16; const size_t off = (size_t)row * DM + col0; float s = 0.f;
#pragma unroll
                for (int bj = 0; bj < 2; ++bj)
#pragma unroll
                    for (int n = 0; n < 2; ++n) { const f32x4 bs = *(const f32x4*)(base + off + bj * HALF + n * 16); const f32x4 v = bs + acc[ai][bj][m][n] + bv[bj][n];
                        *(f32x4*)(out + off + bj * HALF + n * 16) = v; u32x2 w; w.x = cvt_pk_bf16(v[0], v[1]); w.y = cvt_pk_bf16(v[2], v[3]);
                        *(u32x2*)(hb + off + bj * HALF + n * 16) = w; s += (v[0] * v[0] + v[1] * v[1]) + (v[2] * v[2] + v[3] * v[3]); }
                s += __shfl_xor(s, 16); s += __shfl_xor(s, 32);
                if (fq == 0) atomicAdd(ssq_out + row, s);
                asm volatile("" ::: "memory"); }
    }
};

template <class Epi, class Sched, bool ALIGN_EPI = false, bool SP2 = false>
__device__ __forceinline__ void gemm_phase(PG8_LAS unsigned char* lds, const Gemm g, const Sched& S, const Epi& E) {
    int tid_l = threadIdx.x; asm volatile("" : "+v"(tid_l));
    const int tid = tid_l, wid = __builtin_amdgcn_readfirstlane(tid >> 6), lane = tid & 63, wr = wid >> 2, wc = wid & 3, fr = lane & 15, fq = lane >> 4;
    const int K = g.K, nt = K / BK;
    unsigned voffA[2], voffB[2];
#pragma unroll
    for (int i = 0; i < 2; ++i) { int R, C; stage_rc(tid * 16 + i * 8192, R, C); const int Rb = Epi::PERM ? ((R & ~31) + perm32(R & 31)) : R;
        voffA[i] = (unsigned)(R * K + C) * 2u; voffB[i] = (unsigned)(Rb * K + C) * 2u; }
    const size_t kstep = (size_t)(BK * 2);
    const size_t hstep = (size_t)HALF * K * 2;
    const size_t tstep = 2 * hstep;
    const unsigned ldsw = (unsigned)wid * 1024u;
    const int aoff = lds_byte(wr * 64 + fr, fq * 8), boff = lds_byte(wc * 32 + fr, fq * 8);
#define PG8_SA(b, h) (((b) * 2 + (h)) * HTB)
#define PG8_SB(b, h) ((4 + (b) * 2 + (h)) * HTB)
#define PG8_STAGE(bufoff, gbase, voff) do { _Pragma("unroll") for (int _i = 0; _i < 2; ++_i) \
        __builtin_amdgcn_global_load_lds((const unsigned*)((const char*)(gbase) + (voff)[_i]), (PG8_LAS unsigned*)(lds + (bufoff) + ldsw + _i * 8192), 16, 0, 0); } while (0)
#define PG8_LDA(dst, b, h) do { _Pragma("unroll") for (int m = 0; m < 4; ++m) _Pragma("unroll") for (int k = 0; k < 2; ++k) dst[m][k] = *(const PG8_LAS bf16x8*)(lds + PG8_SA(b, h) + aoff + m * 2048 + k * 1024); } while (0)
#define PG8_LDB(dst, b, h) do { _Pragma("unroll") for (int n = 0; n < 2; ++n) _Pragma("unroll") for (int k = 0; k < 2; ++k) dst[n][k] = *(const PG8_LAS bf16x8*)(lds + PG8_SB(b, h) + boff + n * 2048 + k * 1024); } while (0)
#define PG8_MMA(ai, bj, At, Bt) do { __builtin_amdgcn_s_setprio(1); _Pragma("unroll") for (int m = 0; m < 4; ++m) _Pragma("unroll") for (int n = 0; n < 2; ++n) _Pragma("unroll") for (int k = 0; k < 2; ++k) \
        acc[ai][bj][m][n] = __builtin_amdgcn_mfma_f32_16x16x32_bf16(Bt[n][k], At[m][k], acc[ai][bj][m][n], 0, 0, 0); __builtin_amdgcn_s_setprio(0); } while (0)
#define PG8_WAIT_V(n) asm volatile("s_waitcnt vmcnt(" #n ")" ::: "memory")
#define PG8_WAIT_L(n) asm volatile("s_waitcnt lgkmcnt(" #n ")" ::: "memory")
#define PG8_BAR __builtin_amdgcn_s_barrier()
#define PG8_SCHED __builtin_amdgcn_sched_barrier(0)
    Unit cur, nxt; int ui = 0;
    if (!S.next(0, cur)) return;
    f32x4 acc[2][2][4][2];
#pragma unroll
    for (int a = 0; a < 2; ++a)
#pragma unroll
        for (int b = 0; b < 2; ++b)
#pragma unroll
            for (int m = 0; m < 4; ++m)
#pragma unroll
                for (int n = 0; n < 2; ++n) acc[a][b][m][n] = (f32x4){0.f, 0.f, 0.f, 0.f};
    bf16x8 At[4][2], B0[2][2], B1[2][2];
    const char* cA = (const char*)g.A + (size_t)cur.pm * tstep; const char* cB = (const char*)g.Bt + (size_t)cur.pn * tstep;
    S.a_ready(cur);
    if constexpr (SP2) {
        PG8_STAGE(PG8_SB(0, 0), cB, voffB); PG8_STAGE(PG8_SB(0, 1), cB + hstep, voffB); PG8_STAGE(PG8_SA(0, 0), cA, voffA); PG8_STAGE(PG8_SA(0, 1), cA + hstep, voffA);
        if (wr == 1) PG8_BAR;
        PG8_WAIT_V(2); PG8_BAR;
        PG8_STAGE(PG8_SB(1, 0), cB + kstep, voffB); PG8_STAGE(PG8_SA(1, 0), cA + kstep, voffA); PG8_STAGE(PG8_SB(1, 1), cB + hstep + kstep, voffB);
        PG8_WAIT_V(6); PG8_BAR;
    } else {
        PG8_STAGE(PG8_SB(0, 0), cB, voffB); PG8_STAGE(PG8_SA(0, 0), cA, voffA); PG8_STAGE(PG8_SB(0, 1), cB + hstep, voffB); PG8_STAGE(PG8_SA(0, 1), cA + hstep, voffA);
        if (wr == 1) PG8_BAR;
        PG8_WAIT_V(4); PG8_BAR;
        PG8_STAGE(PG8_SB(1, 0), cB + kstep, voffB); PG8_STAGE(PG8_SA(1, 0), cA + kstep, voffA); PG8_STAGE(PG8_SB(1, 1), cB + hstep + kstep, voffB);
        PG8_WAIT_V(6); PG8_BAR;
    }
    for (;;) {
        const bool has_next = S.next(ui + 1, nxt);
        const char* nA = has_next ? (const char*)g.A + (size_t)nxt.pm * tstep : cA; const char* nB = has_next ? (const char*)g.Bt + (size_t)nxt.pn * tstep : cB;
        for (int t = 0; t < nt; t += 2) {
            const bool last = (t == nt - 2);
            const char* a1 = cA + (size_t)(t + 1) * kstep;
            const char* a2 = last ? nA : cA + (size_t)(t + 2) * kstep; const char* b2 = last ? nB : cB + (size_t)(t + 2) * kstep;
            const char* a3 = a2 + kstep; const char* b3 = b2 + kstep;
            if (last && has_next) S.a_ready(nxt);
            if constexpr (SP2) {
            PG8_LDB(B0, 0, 0); PG8_LDB(B1, 0, 1); PG8_SCHED; PG8_LDA(At, 0, 0); PG8_STAGE(PG8_SA(1, 1), a1 + hstep, voffA);
            PG8_WAIT_V(8); PG8_WAIT_L(0); PG8_BAR; PG8_MMA(0, 0, At, B0); PG8_MMA(0, 1, At, B1); PG8_BAR; PG8_SCHED;
            PG8_LDA(At, 0, 1); PG8_STAGE(PG8_SB(0, 0), b2, voffB); PG8_STAGE(PG8_SB(0, 1), b2 + hstep, voffB); PG8_STAGE(PG8_SA(0, 0), a2, voffA);
            PG8_WAIT_V(8); PG8_WAIT_L(0); PG8_BAR; PG8_MMA(1, 0, At, B0); PG8_MMA(1, 1, At, B1); PG8_BAR; PG8_SCHED;
            PG8_LDB(B0, 1, 0); PG8_LDB(B1, 1, 1); PG8_SCHED; PG8_LDA(At, 1, 0); PG8_STAGE(PG8_SA(0, 1), a2 + hstep, voffA);
            PG8_WAIT_V(8); PG8_WAIT_L(0); PG8_BAR; PG8_MMA(0, 0, At, B0); PG8_MMA(0, 1, At, B1); PG8_BAR; PG8_SCHED;
            PG8_LDA(At, 1, 1); PG8_STAGE(PG8_SB(1, 0), b3, voffB); PG8_STAGE(PG8_SB(1, 1), b3 + hstep, voffB); PG8_STAGE(PG8_SA(1, 0), a3, voffA);
            PG8_WAIT_V(8); PG8_WAIT_L(0); PG8_BAR; PG8_MMA(1, 0, At, B0); PG8_MMA(1, 1, At, B1); PG8_BAR; PG8_SCHED;
            } else {
            PG8_LDB(B0, 0, 0); PG8_SCHED; PG8_LDA(At, 0, 0); PG8_STAGE(PG8_SA(1, 1), a1 + hstep, voffA);
            PG8_WAIT_L(8); PG8_BAR; PG8_WAIT_L(0); PG8_MMA(0, 0, At, B0); PG8_BAR; PG8_SCHED;
            PG8_LDB(B1, 0, 1); PG8_STAGE(PG8_SB(0, 0), b2, voffB);
            PG8_BAR; PG8_WAIT_L(0); PG8_MMA(0, 1, At, B1); PG8_BAR;
            PG8_LDA(At, 0, 1); PG8_STAGE(PG8_SA(0, 0), a2, voffA);
            PG8_BAR; PG8_WAIT_L(0); PG8_MMA(1, 0, At, B0); PG8_BAR; PG8_SCHED;
            PG8_STAGE(PG8_SB(0, 1), b2 + hstep, voffB);
            PG8_WAIT_V(6); PG8_BAR; PG8_MMA(1, 1, At, B1); PG8_BAR;
            PG8_LDB(B0, 1, 0); PG8_SCHED; PG8_LDA(At, 1, 0); PG8_STAGE(PG8_SA(0, 1), a2 + hstep, voffA);
            PG8_WAIT_L(8); PG8_BAR; PG8_WAIT_L(0); PG8_MMA(0, 0, At, B0); PG8_BAR; PG8_SCHED;
            PG8_LDB(B1, 1, 1); PG8_STAGE(PG8_SB(1, 0), b3, voffB);
            PG8_BAR; PG8_WAIT_L(0); PG8_MMA(0, 1, At, B1); PG8_BAR;
            PG8_LDA(At, 1, 1); PG8_STAGE(PG8_SA(1, 0), a3, voffA);
            PG8_BAR; PG8_WAIT_L(0); PG8_MMA(1, 0, At, B0); PG8_BAR; PG8_SCHED;
            PG8_STAGE(PG8_SB(1, 1), b3 + hstep, voffB);
            PG8_WAIT_V(6); PG8_BAR; PG8_MMA(1, 1, At, B1); PG8_BAR;
            }
        }
        if constexpr (ALIGN_EPI) { if (wr == 0) PG8_BAR; }
        if constexpr (!Epi::AFTER_DRAIN) { E(acc, cur, wr, wc, fr, fq); S.done(cur); }
        if (!has_next) break;
#pragma unroll
        for (int a = 0; a < 2; ++a)
#pragma unroll
            for (int b = 0; b < 2; ++b)
#pragma unroll
                for (int m = 0; m < 4; ++m)
#pragma unroll
                    for (int n = 0; n < 2; ++n) acc[a][b][m][n] = (f32x4){0.f, 0.f, 0.f, 0.f};
        cur = nxt; cA = nA; cB = nB; ++ui;
        if constexpr (ALIGN_EPI) { if (wr == 1) PG8_BAR; }
    }
    PG8_WAIT_V(0);
    if constexpr (!ALIGN_EPI) { if (wr == 0) PG8_BAR; }
    PG8_BAR;
    if constexpr (Epi::AFTER_DRAIN) { E.fused(acc, cur, wr, wc, fr, fq, lds, wid, lane); S.done(cur); }
#undef PG8_SA
#undef PG8_SB
#undef PG8_STAGE
#undef PG8_LDA
#undef PG8_LDB
#undef PG8_MMA
#undef PG8_WAIT_V
#undef PG8_WAIT_L
#undef PG8_BAR
#undef PG8_SCHED
}
}

#define LAS __attribute__((address_space(3)))
typedef unsigned short bf16;
typedef unsigned v4u __attribute__((ext_vector_type(4)));
typedef unsigned v2u __attribute__((ext_vector_type(2)));
typedef float f32x4 __attribute__((ext_vector_type(4)));
typedef float f32x16 __attribute__((ext_vector_type(16)));
typedef short bf16x8 __attribute__((ext_vector_type(8)));
using pg8::cvt_pk_bf16;

constexpr int NWAVES = 8;
constexpr int BATCH = 8, SEQ = 4096, D = 1024, FF = 4096, M = BATCH * SEQ;
constexpr size_t MiB = 1u << 20;
constexpr size_t WS_SSQ = 0;
constexpr size_t WS_TAB = 1536 * 1024;
constexpr size_t WS_WA_QKV = 2 * MiB, WS_WA_O = 8 * MiB, WA_STRIDE = 8 * MiB;
constexpr size_t WS_WB_Q0 = 18 * MiB;
constexpr size_t WS_WB_Q1 = 21 * MiB;
constexpr size_t WS_WB_O = 23 * MiB;
constexpr size_t WS_WUP = 27 * MiB, WS_WDN = 35 * MiB, WM_STRIDE = 16 * MiB;
constexpr size_t WS_HB = 92 * MiB;
constexpr size_t WS_KSH = 156 * MiB, WS_VTSH = 164 * MiB;
constexpr size_t WS_BIG = 172 * MiB;
constexpr size_t WS_END = 428 * MiB;
constexpr int LDS_BYTES = 147456;

__device__ __forceinline__ float wave_sum(float v) {
#pragma unroll
    for (int o = 1; o < 64; o <<= 1) v += __shfl_xor(v, o);
    return v;
}
typedef float f32x2_t __attribute__((ext_vector_type(2))); typedef __bf16 bf16x2_t __attribute__((ext_vector_type(2)));
__device__ __forceinline__ unsigned pk2(float lo, float hi) { f32x2_t v = {lo, hi}; bf16x2_t b = __builtin_convertvector(v, bf16x2_t); return __builtin_bit_cast(unsigned, b); }

__device__ __forceinline__ void transpose_item(const float* W, const float* gain, int K, int N, bf16* WT, int row_off, LAS float* scr, int item, int lane) {
    const int nblk = N / 32, kb = item / nblk, nb = item % nblk, k0 = 64 * kb, n0 = 32 * nb;
#pragma unroll 8
    for (int i = 0; i < 32; ++i) { const int kk = 2 * i + (lane >> 5); const float g = gain ? gain[k0 + kk] : 1.0f; scr[kk * 33 + (lane & 31)] = W[(size_t)(k0 + kk) * N + n0 + (lane & 31)] * g; }
    asm volatile("s_waitcnt lgkmcnt(0)" ::: "memory");
    const int c = lane & 7;
#pragma unroll
    for (int j = 0; j < 4; ++j) { const int n = (lane >> 3) + 8 * j; const LAS float* s = scr + (8 * c) * 33 + n;
        v4u o; o.x = pk2(s[0 * 33], s[1 * 33]); o.y = pk2(s[2 * 33], s[3 * 33]); o.z = pk2(s[4 * 33], s[5 * 33]); o.w = pk2(s[6 * 33], s[7 * 33]);
        *(v4u*)(WT + (size_t)(row_off + n0 + n) * K + k0 + 8 * c) = o; }
    asm volatile("s_waitcnt lgkmcnt(0)" ::: "memory");
}

__device__ __forceinline__ int pi32(int m) { return (m & ~12) | ((m & 4) << 1) | ((m & 8) >> 1); }
#define MFMA32(a, b, c) __builtin_amdgcn_mfma_f32_32x32x16_bf16((a), (b), (c), 0, 0, 0)
constexpr float LOG2E = 1.4426950408889634f, LN2 = 0.6931471805599453f;

__device__ __forceinline__ void sb_attn_phase(const bf16* Q, const bf16* K, const bf16* VT, bf16* O, int gw, int ngw, int lane_in) {
    int lane = lane_in; asm volatile("" : "+v"(lane));
    const int ql = lane & 31, hi = lane >> 5, kperm = pi32(ql);
    for (int unit = gw; unit < BATCH * 16 * (SEQ / 32); unit += ngw) {
        const int qt = unit & 127, bh = unit >> 7, h = bh & 15, b = bh >> 4, q0 = qt * 32, t = q0 + ql;
        const size_t tok0 = (size_t)b * SEQ;
        const bf16* qp = Q + (tok0 + q0 + ql) * D + h * 64 + 8 * hi;
        bf16x8 qf[4];
#pragma unroll
        for (int kk = 0; kk < 4; ++kk) qf[kk] = *(const bf16x8*)(qp + 16 * kk);
        f32x16 o0, o1;
#pragma unroll
        for (int r = 0; r < 16; ++r) { o0[r] = 0.f; o1[r] = 0.f; }
        float carry = 0.f;
        const bf16* kbase = K + tok0 * D + h * 64 + 8 * hi;
        const bf16* vbase = VT + ((size_t)(b * D + h * 64 + ql)) * SEQ + 8 * hi;
        for (int jb = q0 >> 6; jb >= 0; --jb) {
            const int k0 = jb * 64;
            bf16x8 kf[2][4], vf[2][4];
#pragma unroll
            for (int hf = 0; hf < 2; ++hf)
#pragma unroll
                for (int kk = 0; kk < 4; ++kk) kf[hf][kk] = *(const bf16x8*)(kbase + (size_t)(k0 + 32 * hf + kperm) * D + 16 * kk);
#pragma unroll
            for (int dh = 0; dh < 2; ++dh)
#pragma unroll
                for (int c = 0; c < 4; ++c) vf[dh][c] = *(const bf16x8*)(vbase + (size_t)(32 * dh) * SEQ + k0 + 16 * c);
            f32x16 p0, p1;
#pragma unroll
            for (int r = 0; r < 16; ++r) { p0[r] = 0.f; p1[r] = 0.f; }
#pragma unroll
            for (int kk = 0; kk < 4; ++kk) { p0 = MFMA32(kf[0][kk], qf[kk], p0); p1 = MFMA32(kf[1][kk], qf[kk], p1); }
            float L[4][8], ls[4][8], cs[4], pcs[4];
#pragma unroll
            for (int c = 0; c < 4; ++c) { float acc = 0.f;
#pragma unroll
                for (int i = 0; i < 8; ++i) {
                    const float z = ((c < 2) ? p0[8 * (c & 1) + i] : p1[8 * (c & 1) + i]) * 0.125f;
                    const bool valid = (k0 + 16 * c + 8 * hi + i) < t;
                    const float e = __builtin_amdgcn_exp2f(-fabsf(z) * LOG2E);
                    const float sp = __builtin_amdgcn_logf(1.0f + e) * LN2;
                    L[c][i] = valid ? -(fmaxf(z, 0.f) + sp) : 0.f;
                    ls[c][i] = valid ? (fminf(z, 0.f) - sp) : -1e30f;
                    acc += L[c][i]; }
                cs[c] = acc; }
#pragma unroll
            for (int c = 0; c < 4; ++c) pcs[c] = __shfl_xor(cs[c], 32);
            float run = carry;
            bf16x8 wf[4];
#pragma unroll
            for (int c = 3; c >= 0; --c) {
                float r_ = run + (hi == 0 ? pcs[c] : 0.f);
                float w[8];
#pragma unroll
                for (int i = 7; i >= 0; --i) { w[i] = __builtin_amdgcn_exp2f((ls[c][i] + r_) * LOG2E); r_ += L[c][i]; }
                v4u pk; pk.x = pk2(w[0], w[1]); pk.y = pk2(w[2], w[3]); pk.z = pk2(w[4], w[5]); pk.w = pk2(w[6], w[7]);
                wf[c] = __builtin_bit_cast(bf16x8, pk);
                run += cs[c] + pcs[c]; }
            carry = run;
#pragma unroll
            for (int c = 0; c < 4; ++c) { o0 = MFMA32(vf[0][c], wf[c], o0); o1 = MFMA32(vf[1][c], wf[c], o1); }
            if (__all(carry < -104.0f)) break;
        }
        bf16* op = O + (tok0 + q0 + ql) * D + h * 64 + 4 * hi;
#pragma unroll
        for (int g = 0; g < 4; ++g) {
            v2u a; a.x = pk2(o0[4 * g], o0[4 * g + 1]); a.y = pk2(o0[4 * g + 2], o0[4 * g + 3]); *(v2u*)(op + 8 * g) = a;
            v2u c; c.x = pk2(o1[4 * g], o1[4 * g + 1]); c.y = pk2(o1[4 * g + 2], o1[4 * g + 3]); *(v2u*)(op + 32 + 8 * g) = c; }
    }
}

__device__ __forceinline__ void swa_attn_phase(const bf16* Q, const bf16* Ksh, const bf16* VTsh, bf16* O, const float* sinks, const LAS float* tab, int gw, int ngw, int lane_in) {
    int lane = lane_in; asm volatile("" : "+v"(lane));
    const int ql = lane & 31, hi = lane >> 5, kperm = pi32(ql);
    for (int unit = gw; unit < BATCH * 16 * (SEQ / 32); unit += ngw) {
        const int qt = unit & 127, bh = unit >> 7, qh = bh & 15, b = bh >> 4, kvh = qh >> 3, q0 = qt * 32, t = q0 + ql;
        const size_t tok0 = (size_t)b * SEQ;
        const bf16* qp = Q + (tok0 + q0 + ql) * D + qh * 64 + 8 * hi;
        bf16x8 qf[4];
#pragma unroll
        for (int kk = 0; kk < 4; ++kk) qf[kk] = *(const bf16x8*)(qp + 16 * kk);
        const float sink = sinks[qh];
        const LAS float* tb = tab + qh * 128;
        f32x16 p[5];
        float mx = sink;
#pragma unroll
        for (int j = 0; j < 5; ++j) {
            const int k0 = q0 - 128 + 32 * j;
#pragma unroll
            for (int r = 0; r < 16; ++r) p[j][r] = 0.f;
            if (k0 >= 0) {
                const bf16* kp = Ksh + (tok0 + k0 + kperm) * 128 + kvh * 64 + 8 * hi;
#pragma unroll
                for (int kk = 0; kk < 4; ++kk) { const bf16x8 kf = *(const bf16x8*)(kp + 16 * kk); p[j] = MFMA32(kf, qf[kk], p[j]); }
            }
#pragma unroll
            for (int r = 0; r < 16; ++r) {
                const int dist = t - (k0 + 16 * (r >> 3) + 8 * hi + (r & 7));
                const bool valid = (k0 >= 0) && dist >= 0 && dist < 128;
                const float s = valid ? (p[j][r] * 0.125f + tb[dist & 127]) : -1e30f;
                p[j][r] = s; mx = fmaxf(mx, s); }
        }
        mx = fmaxf(mx, __shfl_xor(mx, 32));
        float sum = 0.f;
        bf16x8 pf[5][2];
#pragma unroll
        for (int j = 0; j < 5; ++j) {
            float e[16];
#pragma unroll
            for (int r = 0; r < 16; ++r) { e[r] = __builtin_amdgcn_exp2f((p[j][r] - mx) * LOG2E); sum += e[r]; }
#pragma unroll
            for (int a = 0; a < 2; ++a) { v4u pk; pk.x = pk2(e[8 * a], e[8 * a + 1]); pk.y = pk2(e[8 * a + 2], e[8 * a + 3]); pk.z = pk2(e[8 * a + 4], e[8 * a + 5]); pk.w = pk2(e[8 * a + 6], e[8 * a + 7]);
                pf[j][a] = __builtin_bit_cast(bf16x8, pk); }
        }
        sum += __shfl_xor(sum, 32);
        sum += __builtin_amdgcn_exp2f((sink - mx) * LOG2E);
        const float inv = 1.0f / sum;
        f32x16 o0, o1;
#pragma unroll
        for (int r = 0; r < 16; ++r) { o0[r] = 0.f; o1[r] = 0.f; }
        const bf16* vbase = VTsh + ((size_t)(b * 128 + kvh * 64 + ql)) * SEQ + 8 * hi;
#pragma unroll
        for (int j = 0; j < 5; ++j) {
            const int k0 = q0 - 128 + 32 * j;
            if (k0 >= 0) {
#pragma unroll
                for (int a = 0; a < 2; ++a) {
                    const bf16x8 v0 = *(const bf16x8*)(vbase + k0 + 16 * a);
                    const bf16x8 v1 = *(const bf16x8*)(vbase + (size_t)32 * SEQ + k0 + 16 * a);
                    o0 = MFMA32(v0, pf[j][a], o0); o1 = MFMA32(v1, pf[j][a], o1); }
            }
        }
        bf16* op = O + (tok0 + q0 + ql) * D + qh * 64 + 4 * hi;
#pragma unroll
        for (int g = 0; g < 4; ++g) {
            v2u a; a.x = pk2(o0[4 * g] * inv, o0[4 * g + 1] * inv); a.y = pk2(o0[4 * g + 2] * inv, o0[4 * g + 3] * inv); *(v2u*)(op + 8 * g) = a;
            v2u c; c.x = pk2(o1[4 * g] * inv, o1[4 * g + 1] * inv); c.y = pk2(o1[4 * g + 2] * inv, o1[4 * g + 3] * inv); *(v2u*)(op + 32 + 8 * g) = c; }
    }
}


__device__ __forceinline__ float bf2f(bf16 v) { return __uint_as_float((unsigned)v << 16); }
__device__ __forceinline__ void sb_attn_naive(const bf16* Q, const bf16* K, const bf16* VT, bf16* O, int gtid_in, int gthreads) {
    int gtid = gtid_in; asm volatile("" : "+v"(gtid));
    for (int idx = gtid; idx < BATCH * 16 * SEQ; idx += gthreads) {
        const int t = idx & 4095, bh = idx >> 12, h = bh & 15, b = bh >> 4;
        const size_t tok0 = (size_t)b * SEQ;
        float o[64]; const bf16* q = Q + (tok0 + t) * D + h * 64;
#pragma unroll
        for (int d = 0; d < 64; ++d) o[d] = 0.f;
        float carry = 0.f;
        for (int s = t - 1; s >= 0; --s) {
            float z = 0.f;
#pragma unroll
            for (int d = 0; d < 64; ++d) z += bf2f(q[d]) * bf2f(K[(tok0 + s) * D + h * 64 + d]);
            z *= 0.125f;
            const float sp = __builtin_amdgcn_logf(1.0f + __builtin_amdgcn_exp2f(-fabsf(z) * 1.4426950408889634f)) * 0.6931471805599453f;
            const float w = __builtin_amdgcn_exp2f((fminf(z, 0.f) - sp + carry) * 1.4426950408889634f);
            carry += -(fmaxf(z, 0.f) + sp);
#pragma unroll
            for (int d = 0; d < 64; ++d) o[d] += w * bf2f(VT[((size_t)(b * D + h * 64 + d)) * SEQ + s]);
            if (carry < -104.f) break;
        }
#pragma unroll
        for (int d = 0; d < 64; ++d) O[(tok0 + t) * D + h * 64 + d] = pg8::bf1(o[d]);
    }
}
__device__ __forceinline__ void swa_attn_naive(const bf16* Q, const bf16* Ksh, const bf16* VTsh, bf16* O, const float* sinks, const float* tabg, int gtid_in, int gthreads) {
    int gtid = gtid_in; asm volatile("" : "+v"(gtid));
    for (int idx = gtid; idx < BATCH * 16 * SEQ; idx += gthreads) {
        const int t = idx & 4095, bh = idx >> 12, qh = bh & 15, b = bh >> 4, kvh = qh >> 3;
        const size_t tok0 = (size_t)b * SEQ;
        float o[64]; const bf16* q = Q + (tok0 + t) * D + qh * 64;
#pragma unroll
        for (int d = 0; d < 64; ++d) o[d] = 0.f;
        const float sink = sinks[qh];
        float mx = sink, sum = 0.f;
        const int s_lo = t - 127 > 0 ? t - 127 : 0;
        for (int s = s_lo; s <= t; ++s) {
            float z = 0.f;
#pragma unroll
            for (int d = 0; d < 64; ++d) z += bf2f(q[d]) * bf2f(Ksh[(tok0 + s) * 128 + kvh * 64 + d]);
            z = z * 0.125f + tabg[qh * 128 + (t - s)];
            const float nm = fmaxf(mx, z), sc = __builtin_amdgcn_exp2f((mx - nm) * 1.4426950408889634f), e = __builtin_amdgcn_exp2f((z - nm) * 1.4426950408889634f);
            sum = sum * sc + e; mx = nm;
#pragma unroll
            for (int d = 0; d < 64; ++d) o[d] = o[d] * sc + e * bf2f(VTsh[((size_t)(b * 128 + kvh * 64 + d)) * SEQ + s]);
        }
        sum += __builtin_amdgcn_exp2f((sink - mx) * 1.4426950408889634f);
        const float inv = 1.0f / sum;
#pragma unroll
        for (int d = 0; d < 64; ++d) O[(tok0 + t) * D + qh * 64 + d] = pg8::bf1(o[d] * inv);
    }
}
#ifndef ONLY
#define ONLY -1
#endif
#define PH(n) (ONLY < 0 || ONLY == (n))
struct Args { const float* in[18]; float* out; unsigned char* ws; };

__global__ void __launch_bounds__(NWAVES * 64, 2) yoco_fwd(Args args) {
    extern __shared__ __attribute__((aligned(16))) unsigned char lds_raw[];
    cg::grid_group grid = cg::this_grid();
    LAS unsigned char* lds = (LAS unsigned char*)lds_raw;
    const int tid = threadIdx.x, lane = tid & 63, wave = __builtin_amdgcn_readfirstlane(tid >> 6);
    const int G = gridDim.x, bx = blockIdx.x;
    const int vcu = (G % 8 == 0) ? (bx % 8) * (G / 8) + bx / 8 : bx;
    const int gw = vcu * NWAVES + wave, NGW = G * NWAVES;
    volatile LAS unsigned long long* slots = (volatile LAS unsigned long long*)(lds + 131072 + 2048);
    if (tid == 0) {
#pragma unroll
        for (int i = 0; i < 18; ++i) slots[i] = (unsigned long long)args.in[i];
        slots[18] = (unsigned long long)args.out; slots[19] = (unsigned long long)args.ws;
    }
    __syncthreads();
#define GP(i) ((const float*)(((unsigned long long)(unsigned)__builtin_amdgcn_readfirstlane((unsigned)(slots[i] >> 32)) << 32) | (unsigned long long)(unsigned)__builtin_amdgcn_readfirstlane((unsigned)slots[i])))
#define P_x GP(0)
#define P_a_norm GP(1)
#define P_a_wqkv GP(2)
#define P_a_wo GP(3)
#define P_kv_norm GP(4)
#define P_w_kv GP(5)
#define P_b_kv GP(6)
#define P_b_norm GP(7)
#define P_b_wq GP(8)
#define P_b_bq GP(9)
#define P_b_sinks GP(10)
#define P_b_wo GP(11)
#define P_b_bo GP(12)
#define P_rel_bias GP(13)
#define P_mlp_norm GP(14)
#define P_mlp_up GP(15)
#define P_mlp_down GP(16)
#define P_final_norm GP(17)
#define P_out ((float*)GP(18))
#define P_ws ((unsigned char*)GP(19))
#define P_ssq ((float*)(P_ws + WS_SSQ))
#define P_tabg ((float*)(P_ws + WS_TAB))
#define P_HB ((bf16*)(P_ws + WS_HB))
#define P_KSH ((bf16*)(P_ws + WS_KSH))
#define P_VTSH ((bf16*)(P_ws + WS_VTSH))
#define P_U ((bf16*)(P_ws + WS_BIG))
#define P_Qb ((bf16*)(P_ws + WS_BIG))
#define P_Kb ((bf16*)(P_ws + WS_BIG + 64 * MiB))
#define P_VTb ((bf16*)(P_ws + WS_BIG + 128 * MiB))
#define P_Ob ((bf16*)(P_ws + WS_BIG + 192 * MiB))

    if (PH(0)) {
        LAS float* scr = (LAS float*)(lds + wave * 16384);
        constexpr int I_QKV = (D / 64) * (3 * D / 32), I_DD = (D / 64) * (D / 32), I_KV = (D / 64) * (256 / 32), I_UP = (D / 64) * (FF / 32), I_DN = (FF / 64) * (D / 32);
        constexpr int NITEMS = 2 * (I_QKV + I_DD) + (I_DD + I_KV) + I_DD + 2 * I_DD + 4 * (I_UP + I_DN);
        for (int it = gw; it < NITEMS; it += NGW) {
            int r = it; bool done = false;
#pragma unroll
            for (int l = 0; l < 2; ++l) {
                if (!done && r < I_QKV) { transpose_item(P_a_wqkv + (size_t)l * D * 3 * D, P_a_norm + l * D, D, 3 * D, (bf16*)(P_ws + WS_WA_QKV + l * WA_STRIDE), 0, scr, r, lane); done = true; } if (!done) r -= I_QKV;
                if (!done && r < I_DD) { transpose_item(P_a_wo + (size_t)l * D * D, nullptr, D, D, (bf16*)(P_ws + WS_WA_O + l * WA_STRIDE), 0, scr, r, lane); done = true; } if (!done) r -= I_DD;
            }
            if (!done && r < I_DD) { transpose_item(P_b_wq, P_b_norm, D, D, (bf16*)(P_ws + WS_WB_Q0), 0, scr, r, lane); done = true; } if (!done) r -= I_DD;
            if (!done && r < I_KV) { transpose_item(P_w_kv, P_kv_norm, D, 256, (bf16*)(P_ws + WS_WB_Q0), 1024, scr, r, lane); done = true; } if (!done) r -= I_KV;
            if (!done && r < I_DD) { transpose_item(P_b_wq + (size_t)D * D, P_b_norm + D, D, D, (bf16*)(P_ws + WS_WB_Q1), 0, scr, r, lane); done = true; } if (!done) r -= I_DD;
#pragma unroll
            for (int j = 0; j < 2; ++j) { if (!done && r < I_DD) { transpose_item(P_b_wo + (size_t)j * D * D, nullptr, D, D, (bf16*)(P_ws + WS_WB_O + j * 2 * MiB), 0, scr, r, lane); done = true; } if (!done) r -= I_DD; }
#pragma unroll
            for (int l = 0; l < 4; ++l) {
                if (!done && r < I_UP) { transpose_item(P_mlp_up + (size_t)l * D * FF, P_mlp_norm + l * D, D, FF, (bf16*)(P_ws + WS_WUP + l * WM_STRIDE), 0, scr, r, lane); done = true; } if (!done) r -= I_UP;
                if (!done && r < I_DN) { transpose_item(P_mlp_down + (size_t)l * FF * D, nullptr, FF, D, (bf16*)(P_ws + WS_WDN + l * WM_STRIDE), 0, scr, r, lane); done = true; } if (!done) r -= I_DN;
            }
        }
        for (int m = gw; m < M; m += NGW) {
            const f32x4* xr = (const f32x4*)(P_x + (size_t)m * D) + lane; float s = 0.f;
            unsigned long long* o8 = (unsigned long long*)(P_HB + (size_t)m * D) + lane;
#pragma unroll
            for (int j = 0; j < 4; ++j) { const f32x4 v = xr[64 * j]; s += (v.x * v.x + v.y * v.y) + (v.z * v.z + v.w * v.w);
                o8[64 * j] = (unsigned long long)pk2(v.x, v.y) | ((unsigned long long)pk2(v.z, v.w) << 32); }
            s = wave_sum(s);
            if (lane == 0) P_ssq[m] = s;
        }
        for (int i = bx * (NWAVES * 64) + tid; i < 8 * M; i += G * NWAVES * 64) P_ssq[M + i] = 0.f;
        for (int i = bx * (NWAVES * 64) + tid; i < 16 * 128; i += G * NWAVES * 64) {
            const int h = i >> 7, n = i & 127;
            int bucket = n;
            if (n >= 16) { const int lg = 16 + (int)(logf((float)n / 16.0f) / 2.0794415416798357f * 16.0f); bucket = lg < 31 ? lg : 31; }
            P_tabg[i] = P_rel_bias[bucket * 16 + h];
        }
    }
    grid.sync();

    for (int layer = 0; layer < 4; ++layer) {
        const float* ssq_in = P_ssq + (size_t)(2 * layer) * M;
        float* ssq_mid = P_ssq + (size_t)(2 * layer + 1) * M;
        float* ssq_out = P_ssq + (size_t)(2 * layer + 2) * M;
        const float* resid_in = layer == 0 ? P_x : P_out;
        if (layer < 2) {
            if (PH(1)) { pg8::Gemm g{P_HB, (const bf16*)(P_ws + WS_WA_QKV + layer * WA_STRIDE), M, 3 * D, D}; pg8::StaticOrder S; S.init(M, 3 * D, G, bx);
              pg8::EpiQKV E{P_Qb, P_Kb, P_VTb, ssq_in};
              pg8::gemm_phase<pg8::EpiQKV, pg8::StaticOrder, true, true>(lds, g, S, E); }
            grid.sync();
#ifdef NAIVE_SB
            if (PH(2)) sb_attn_naive(P_Qb, P_Kb, P_VTb, P_Ob, bx * 512 + tid, G * 512);
#else
            if (PH(2)) sb_attn_phase(P_Qb, P_Kb, P_VTb, P_Ob, gw, NGW, lane);
#endif
            grid.sync();
            if (PH(3)) { pg8::Gemm g{P_Ob, (const bf16*)(P_ws + WS_WA_O + layer * WA_STRIDE), M, D, D}; pg8::StaticOrder S; S.init(M, D, G, bx);
              pg8::EpiResid E{resid_in, P_out, P_HB, nullptr, ssq_mid};
              pg8::gemm_phase<pg8::EpiResid, pg8::StaticOrder, true, true>(lds, g, S, E); }
            grid.sync();
        } else {
            const int j = layer - 2;
            if (PH(4)) { if (j == 0) { pg8::Gemm g{P_HB, (const bf16*)(P_ws + WS_WB_Q0), M, 1280, D}; pg8::StaticOrder S; S.init(M, 1280, G, bx);
              pg8::EpiQB<true> E{P_Qb, P_KSH, P_VTSH, P_b_bq, P_b_kv, ssq_in};
              pg8::gemm_phase<pg8::EpiQB<true>, pg8::StaticOrder, true, true>(lds, g, S, E); }
            else { pg8::Gemm g{P_HB, (const bf16*)(P_ws + WS_WB_Q1), M, D, D}; pg8::StaticOrder S; S.init(M, D, G, bx);
              pg8::EpiQB<false> E{P_Qb, P_KSH, P_VTSH, P_b_bq + D, P_b_kv, ssq_in};
              pg8::gemm_phase<pg8::EpiQB<false>, pg8::StaticOrder, true, true>(lds, g, S, E); } }
            { LAS float* tab = (LAS float*)lds; for (int i = tid; i < 16 * 128; i += NWAVES * 64) tab[i] = P_tabg[i]; }
            grid.sync();
#ifdef NAIVE_SWA
            if (PH(5)) swa_attn_naive(P_Qb, P_KSH, P_VTSH, P_Ob, P_b_sinks + j * 16, P_tabg, bx * 512 + tid, G * 512);
#else
            if (PH(5)) swa_attn_phase(P_Qb, P_KSH, P_VTSH, P_Ob, P_b_sinks + j * 16, (const LAS float*)lds, gw, NGW, lane);
#endif
            grid.sync();
            if (PH(3)) { pg8::Gemm g{P_Ob, (const bf16*)(P_ws + WS_WB_O + j * 2 * MiB), M, D, D}; pg8::StaticOrder S; S.init(M, D, G, bx);
              pg8::EpiResid E{resid_in, P_out, P_HB, P_b_bo + j * D, ssq_mid};
              pg8::gemm_phase<pg8::EpiResid, pg8::StaticOrder, true, true>(lds, g, S, E); }
            grid.sync();
        }
        if (PH(6)) { pg8::Gemm g{P_HB, (const bf16*)(P_ws + WS_WUP + layer * WM_STRIDE), M, FF, D}; pg8::StaticOrder S; S.init(M, FF, G, bx);
          pg8::EpiUp E{P_U, ssq_mid};
          pg8::gemm_phase<pg8::EpiUp, pg8::StaticOrder, true, true>(lds, g, S, E); }
        grid.sync();
        if (PH(7)) { pg8::Gemm g{P_U, (const bf16*)(P_ws + WS_WDN + layer * WM_STRIDE), M, D, FF}; pg8::StaticOrder S; S.init(M, D, G, bx);
          pg8::EpiResid E{P_out, P_out, P_HB, nullptr, ssq_out};
          pg8::gemm_phase<pg8::EpiResid, pg8::StaticOrder, true, true>(lds, g, S, E); }
        grid.sync();
    }
    if (PH(8)) {
        const float* ssq_fin = P_ssq + (size_t)8 * M;
        f32x4 gv[4];
#pragma unroll
        for (int j = 0; j < 4; ++j) gv[j] = ((const f32x4*)P_final_norm)[lane + 64 * j];
        for (int m = gw; m < M; m += NGW) {
            f32x4* xr = (f32x4*)(P_out + (size_t)m * D) + lane; const float rs = pg8::rstd_of(ssq_fin[m]);
#pragma unroll
            for (int j = 0; j < 4; ++j) { f32x4 v = xr[64 * j]; v = v * rs * gv[j]; xr[64 * j] = v; }
        }
    }
}

extern "C" void kernel_launch(void* const* d_in, const int* in_sizes, int n_in, void* d_out, int out_size, void* d_ws, size_t ws_size, hipStream_t stream) {
    static int grid = 0;
    if (grid == 0) {
        if (n_in != 18 || out_size != M * D || ws_size < WS_END) { fprintf(stderr, "kernel_launch: unexpected shapes (n_in %d, out %d, ws %zu)\n", n_in, out_size, ws_size); grid = -1; return; }
        int dev = 0, cus = 0, per_cu = 0;
        hipGetDevice(&dev);
        hipDeviceGetAttribute(&cus, hipDeviceAttributeMultiprocessorCount, dev);
        if (hipFuncSetAttribute((const void*)yoco_fwd, hipFuncAttributeMaxDynamicSharedMemorySize, LDS_BYTES) != hipSuccess) { fprintf(stderr, "kernel_launch: hipFuncSetAttribute failed\n"); grid = -1; return; }
        if (hipOccupancyMaxActiveBlocksPerMultiprocessor(&per_cu, (const void*)yoco_fwd, NWAVES * 64, LDS_BYTES) != hipSuccess || per_cu < 1) { fprintf(stderr, "kernel_launch: occupancy query failed (%d)\n", per_cu); per_cu = 1; }
        (void)hipGetLastError();
        grid = cus * per_cu;
        fprintf(stderr, "kernel_launch: grid %d (cus %d x %d)\n", grid, cus, per_cu);
    }
    if (grid < 0) return;
    Args a{};
    for (int i = 0; i < 18; ++i) a.in[i] = (const float*)d_in[i];
    a.out = (float*)d_out; a.ws = (unsigned char*)d_ws;
    void* kargs[] = {&a};
    hipError_t e = hipLaunchCooperativeKernel((const void*)yoco_fwd, dim3(grid), dim3(NWAVES * 64), kargs, LDS_BYTES, stream);
    if (e != hipSuccess) fprintf(stderr, "kernel_launch: cooperative launch failed: %s (grid %d)\n", hipGetErrorString(e), grid);
}
```

```cpp
#include <hip/hip_runtime.h>
#include <hip/hip_cooperative_groups.h>
#include <cstdio>
#include <cstdint>
namespace cg = cooperative_groups;
namespace pg8 {
#define PG8_LAS __attribute__((address_space(3)))
typedef unsigned short bf16_t;
typedef short bf16x8 __attribute__((ext_vector_type(8)));
typedef float f32x4 __attribute__((ext_vector_type(4)));
typedef unsigned u32x4 __attribute__((ext_vector_type(4)));
constexpr int BM = 256, BK = 64, HALF = 128, HTB = HALF * BK * 2  , STAGE_BYTES = 8 * HTB, NXCD = 8, WGM = 8;

__host__ __device__ __forceinline__ int lds_byte(int r, int c) { const int st = (r >> 4) * 2 + (c >> 5), rr = r & 15, cc = c & 31, ob = rr * 64 + cc * 2; return st * 1024 + (ob ^ (((ob >> 9) & 1) << 5)); }
__host__ __device__ __forceinline__ void stage_rc(int b, int& R, int& C) { const int st = b / 1024, sb = b % 1024, swz = sb ^ (((sb >> 9) & 1) << 5); R = (st >> 1) * 16 + swz / 64; C = (st & 1) * 32 + (swz % 64) / 2; }
__host__ __device__ __forceinline__ int perm32(int rho) { const int n = rho >> 4, i = rho & 15; return 8 * (i >> 2) + 4 * n + (i & 3); }

struct Unit { int pm, pn; };
struct Gemm { const bf16_t* A; const bf16_t* Bt; int M, N, K; };

struct StaticOrder {
    int nM, nN, nwg, G, c;
    __host__ __device__ void init(int M, int N, int G_, int c_) { nM = M / BM; nN = N / BM; nwg = nM * nN; G = G_; c = c_; }
    __host__ __device__ bool next(int i, Unit& u) const {
        const long L = (long)i * G + c; if (L >= nwg) return false;
        int wgid = (int)L; { const int q = nwg / NXCD, r = nwg % NXCD, xcd = wgid % NXCD, off = wgid / NXCD; wgid = (xcd < r ? xcd * (q + 1) : r * (q + 1) + (xcd - r) * q) + off; }
        const int nig = WGM * nN, gid = wgid / nig, fm = gid * WGM, gsz = (nM - fm) < WGM ? (nM - fm) : WGM;
        u.pm = fm + ((wgid % nig) % gsz); u.pn = (wgid % nig) / gsz; return true;
    }
    __device__ __forceinline__ void a_ready(const Unit&) const {}
    __device__ __forceinline__ void done(const Unit&) const {}
};

__device__ __forceinline__ unsigned cvt_pk_bf16(float lo, float hi) { unsigned r; asm volatile("v_cvt_pk_bf16_f32 %0, %1, %2" : "=v"(r) : "v"(lo), "v"(hi)); return r; }
typedef float f32x2 __attribute__((ext_vector_type(2)));
typedef unsigned u32x2 __attribute__((ext_vector_type(2)));
constexpr float RMS_EPS = 1e-5f;
constexpr int DM = 1024, SEQ = 4096, FF = 4096;
__device__ __forceinline__ float rstd_of(float ssq) { return 1.0f / sqrtf(ssq * (1.0f / 1024.0f) + RMS_EPS); }
__device__ __forceinline__ unsigned short bf1(float v) { return (unsigned short)(cvt_pk_bf16(v, 0.f) & 0xffffu); }

struct EpiQKV {
    static constexpr bool PERM = true, AFTER_DRAIN = false;
    bf16_t* Q; bf16_t* K; bf16_t* VT; const float* ssq;
    __device__ __forceinline__ void operator()(const f32x4 (&acc)[2][2][4][2], const Unit& u, int wr, int wc, int fr, int fq) const {
        const int row0 = u.pm * BM + wr * 64 + fr;
        const int t = u.pn >> 2, col0 = (u.pn & 3) * BM + wc * 32 + 8 * fq;
        if (t < 2) {
            bf16_t* base = t == 0 ? Q : K;
#pragma unroll
            for (int ai = 0; ai < 2; ++ai)
#pragma unroll
                for (int m = 0; m < 4; ++m) { const int row = row0 + ai * HALF + m * 16; const float rs = rstd_of(ssq[row]); bf16_t* rowp = base + (size_t)row * DM + col0;
#pragma unroll
                    for (int bj = 0; bj < 2; ++bj) { const f32x4 v0 = acc[ai][bj][m][0] * rs, v1 = acc[ai][bj][m][1] * rs; u32x4 w;
                        w.x = cvt_pk_bf16(v0[0], v0[1]); w.y = cvt_pk_bf16(v0[2], v0[3]); w.z = cvt_pk_bf16(v1[0], v1[1]); w.w = cvt_pk_bf16(v1[2], v1[3]);
                        *(u32x4*)(rowp + bj * HALF) = w; } }
        } else {
#pragma unroll
            for (int ai = 0; ai < 2; ++ai)
#pragma unroll
                for (int m = 0; m < 4; ++m) { asm volatile("" ::: "memory"); const int row = row0 + ai * HALF + m * 16; const float rs = rstd_of(ssq[row]); const int b = row >> 12, s = row & 4095;
                    bf16_t* cp = VT + ((size_t)(b * DM + col0)) * SEQ + s;
#pragma unroll
                    for (int bj = 0; bj < 2; ++bj)
#pragma unroll
                        for (int n = 0; n < 2; ++n)
#pragma unroll
                            for (int j = 0; j < 4; ++j) cp[(size_t)(bj * HALF + 4 * n + j) * SEQ] = bf1(acc[ai][bj][m][n][j] * rs); }
        }
    }
};

template <bool HAS_KV> struct EpiQB {
    static constexpr bool PERM = true, AFTER_DRAIN = false;
    bf16_t* Q; bf16_t* Ksh; bf16_t* VTsh; const float* bq; const float* bkv; const float* ssq;
    __device__ __forceinline__ void operator()(const f32x4 (&acc)[2][2][4][2], const Unit& u, int wr, int wc, int fr, int fq) const {
        const int row0 = u.pm * BM + wr * 64 + fr;
        if (!HAS_KV || u.pn < 4) {
            const int col0 = u.pn * BM + wc * 32 + 8 * fq;
#pragma unroll
            for (int ai = 0; ai < 2; ++ai)
#pragma unroll
                for (int m = 0; m < 4; ++m) { const int row = row0 + ai * HALF + m * 16; const float rs = rstd_of(ssq[row]); bf16_t* rowp = Q + (size_t)row * DM + col0;
#pragma unroll
                    for (int bj = 0; bj < 2; ++bj) { const f32x4 b0 = *(const f32x4*)(bq + col0 + bj * HALF), b1 = *(const f32x4*)(bq + col0 + bj * HALF + 4);
                        const f32x4 v0 = acc[ai][bj][m][0] * rs + b0, v1 = acc[ai][bj][m][1] * rs + b1; u32x4 w;
                        w.x = cvt_pk_bf16(v0[0], v0[1]); w.y = cvt_pk_bf16(v0[2], v0[3]); w.z = cvt_pk_bf16(v1[0], v1[1]); w.w = cvt_pk_bf16(v1[2], v1[3]);
                        *(u32x4*)(rowp + bj * HALF) = w; }
                    asm volatile("" ::: "memory"); }
        } else {
            const int c0 = wc * 32 + 8 * fq;
#pragma unroll
            for (int ai = 0; ai < 2; ++ai)
#pragma unroll
                for (int m = 0; m < 4; ++m) { const int row = row0 + ai * HALF + m * 16; const float rs = rstd_of(ssq[row]); const int b = row >> 12, s = row & 4095;
                    { const f32x4 b0 = *(const f32x4*)(bkv + c0), b1 = *(const f32x4*)(bkv + c0 + 4);
                      const f32x4 v0 = acc[ai][0][m][0] * rs + b0, v1 = acc[ai][0][m][1] * rs + b1; u32x4 w;
                      w.x = cvt_pk_bf16(v0[0], v0[1]); w.y = cvt_pk_bf16(v0[2], v0[3]); w.z = cvt_pk_bf16(v1[0], v1[1]); w.w = cvt_pk_bf16(v1[2], v1[3]);
                      *(u32x4*)(Ksh + (size_t)row * 128 + c0) = w; }
                    bf16_t* cp = VTsh + ((size_t)(b * 128 + c0)) * SEQ + s;
#pragma unroll
                    for (int n = 0; n < 2; ++n) { const f32x4 bb = *(const f32x4*)(bkv + 128 + c0 + 4 * n);
#pragma unroll
                        for (int j = 0; j < 4; ++j) cp[(size_t)(4 * n + j) * SEQ] = bf1(acc[ai][1][m][n][j] * rs + bb[j]); }
                    asm volatile("" ::: "memory"); }
        }
    }
};

struct EpiUp {
    static constexpr bool PERM = true, AFTER_DRAIN = false;
    bf16_t* U; const float* ssq;
    __device__ __forceinline__ void operator()(const f32x4 (&acc)[2][2][4][2], const Unit& u, int wr, int wc, int fr, int fq) const {
        const int row0 = u.pm * BM + wr * 64 + fr, col0 = u.pn * BM + wc * 32 + 8 * fq;
#pragma unroll
        for (int ai = 0; ai < 2; ++ai)
#pragma unroll
            for (int m = 0; m < 4; ++m) { const int row = row0 + ai * HALF + m * 16; const float rs = rstd_of(ssq[row]); bf16_t* rowp = U + (size_t)row * FF + col0;
#pragma unroll
                for (int bj = 0; bj < 2; ++bj) { f32x4 v0 = acc[ai][bj][m][0] * rs, v1 = acc[ai][bj][m][1] * rs;
#pragma unroll
                    for (int j = 0; j < 4; ++j) { const float a = fmaxf(v0[j], 0.f), b = fmaxf(v1[j], 0.f); v0[j] = a * a; v1[j] = b * b; }
                    u32x4 w; w.x = cvt_pk_bf16(v0[0], v0[1]); w.y = cvt_pk_bf16(v0[2], v0[3]); w.z = cvt_pk_bf16(v1[0], v1[1]); w.w = cvt_pk_bf16(v1[2], v1[3]);
                    *(u32x4*)(rowp + bj * HALF) = w; } }
    }
};

struct EpiResid {
    static constexpr bool PERM = false, AFTER_DRAIN = false;
    const float* base; float* out; bf16_t* hb; const float* bias; float* ssq_out;
    __device__ __forceinline__ void operator()(const f32x4 (&acc)[2][2][4][2], const Unit& u, int wr, int wc, int fr, int fq) const {
        const int row0 = u.pm * BM + wr * 64 + fr, col0 = u.pn * BM + wc * 32 + 4 * fq;
        f32x4 bv[2][2];
#pragma unroll
        for (int bj = 0; bj < 2; ++bj)
#pragma unroll
            for (int n = 0; n < 2; ++n) bv[bj][n] = bias ? *(const f32x4*)(bias + col0 + bj * HALF + n * 16) : (f32x4){0.f, 0.f, 0.f, 0.f};
#pragma unroll
        for (int ai = 0; ai < 2; ++ai)
#pragma unroll
            for (int m = 0; m < 4; ++m) { const int row = row0 + ai * HALF + m * 16; const size_t off = (size_t)row * DM + col0; float s = 0.f;
#pragma unroll
                for (int bj = 0; bj < 2; ++bj)
#pragma unroll
                    for (int n = 0; n < 2; ++n) { const f32x4 bs = *(const f32x4*)(base + off + bj * HALF + n * 16); const f32x4 v = bs + acc[ai][bj][m][n] + bv[bj][n];
                        *(f32x4*)(out + off + bj * HALF + n * 16) = v; u32x2 w; w.x = cvt_pk_bf16(v[0], v[1]); w.y = cvt_pk_bf16(v[2], v[3]);
                        *(u32x2*)(hb + off + bj * HALF + n * 16) = w; s += (v[0] * v[0] + v[1] * v[1]) + (v[2] * v[2] + v[3] * v[3]); }
                s += __shfl_xor(s, 16); s += __shfl_xor(s, 32);
                if (fq == 0) atomicAdd(ssq_out + row, s);
                asm volatile("" ::: "memory"); }
    }
};

template <class Epi, class Sched, bool ALIGN_EPI = false, bool SP2 = false>
__device__ __forceinline__ void gemm_phase(PG8_LAS unsigned char* lds, const Gemm g, const Sched& S, const Epi& E) {
    int tid_l = threadIdx.x; asm volatile("" : "+v"(tid_l));
    const int tid = tid_l, wid = __builtin_amdgcn_readfirstlane(tid >> 6), lane = tid & 63, wr = wid >> 2, wc = wid & 3, fr = lane & 15, fq = lane >> 4;
    const int K = g.K, nt = K / BK;
    unsigned voffA[2], voffB[2];
#pragma unroll
    for (int i = 0; i < 2; ++i) { int R, C; stage_rc(tid * 16 + i * 8192, R, C); const int Rb = Epi::PERM ? ((R & ~31) + perm32(R & 31)) : R;
        voffA[i] = (unsigned)(R * K + C) * 2u; voffB[i] = (unsigned)(Rb * K + C) * 2u; }
    const size_t kstep = (size_t)(BK * 2);
    const size_t hstep = (size_t)HALF * K * 2;
    const size_t tstep = 2 * hstep;
    const unsigned ldsw = (unsigned)wid * 1024u;
    const int aoff = lds_byte(wr * 64 + fr, fq * 8), boff = lds_byte(wc * 32 + fr, fq * 8);
#define PG8_SA(b, h) (((b) * 2 + (h)) * HTB)
#define PG8_SB(b, h) ((4 + (b) * 2 + (h)) * HTB)
#define PG8_STAGE(bufoff, gbase, voff) do { _Pragma("unroll") for (int _i = 0; _i < 2; ++_i) \
        __builtin_amdgcn_global_load_lds((const unsigned*)((const char*)(gbase) + (voff)[_i]), (PG8_LAS unsigned*)(lds + (bufoff) + ldsw + _i * 8192), 16, 0, 0); } while (0)
#define PG8_LDA(dst, b, h) do { _Pragma("unroll") for (int m = 0; m < 4; ++m) _Pragma("unroll") for (int k = 0; k < 2; ++k) dst[m][k] = *(const PG8_LAS bf16x8*)(lds + PG8_SA(b, h) + aoff + m * 2048 + k * 1024); } while (0)
#define PG8_LDB(dst, b, h) do { _Pragma("unroll") for (int n = 0; n < 2; ++n) _Pragma("unroll") for (int k = 0; k < 2; ++k) dst[n][k] = *(const PG8_LAS bf16x8*)(lds + PG8_SB(b, h) + boff + n * 2048 + k * 1024); } while (0)
#define PG8_MMA(ai, bj, At, Bt) do { __builtin_amdgcn_s_setprio(1); _Pragma("unroll") for (int m = 0; m < 4; ++m) _Pragma("unroll") for (int n = 0; n < 2; ++n) _Pragma("unroll") for (int k = 0; k < 2; ++k) \
        acc[ai][bj][m][n] = __builtin_amdgcn_mfma_f32_16x16x32_bf16(Bt[n][k], At[m][k], acc[ai][bj][m][n], 0, 0, 0); __builtin_amdgcn_s_setprio(0); } while (0)
#define PG8_WAIT_V(n) asm volatile("s_waitcnt vmcnt(" #n ")" ::: "memory")
#define PG8_WAIT_L(n) asm volatile("s_waitcnt lgkmcnt(" #n ")" ::: "memory")
#define PG8_BAR __builtin_amdgcn_s_barrier()
#define PG8_SCHED __builtin_amdgcn_sched_barrier(0)
    Unit cur, nxt; int ui = 0;
    if (!S.next(0, cur)) return;
    f32x4 acc[2][2][4][2];
#pragma unroll
    for (int a = 0; a < 2; ++a)
#pragma unroll
        for (int b = 0; b < 2; ++b)
#pragma unroll
            for (int m = 0; m < 4; ++m)
#pragma unroll
                for (int n = 0; n < 2; ++n) acc[a][b][m][n] = (f32x4){0.f, 0.f, 0.f, 0.f};
    bf16x8 At[4][2], B0[2][2], B1[2][2];
    const char* cA = (const char*)g.A + (size_t)cur.pm * tstep; const char* cB = (const char*)g.Bt + (size_t)cur.pn * tstep;
    S.a_ready(cur);
    if constexpr (SP2) {
        PG8_STAGE(PG8_SB(0, 0), cB, voffB); PG8_STAGE(PG8_SB(0, 1), cB + hstep, voffB); PG8_STAGE(PG8_SA(0, 0), cA, voffA); PG8_STAGE(PG8_SA(0, 1), cA + hstep, voffA);
        if (wr == 1) PG8_BAR;
        PG8_WAIT_V(2); PG8_BAR;
        PG8_STAGE(PG8_SB(1, 0), cB + kstep, voffB); PG8_STAGE(PG8_SA(1, 0), cA + kstep, voffA); PG8_STAGE(PG8_SB(1, 1), cB + hstep + kstep, voffB);
        PG8_WAIT_V(6); PG8_BAR;
    } else {
        PG8_STAGE(PG8_SB(0, 0), cB, voffB); PG8_STAGE(PG8_SA(0, 0), cA, voffA); PG8_STAGE(PG8_SB(0, 1), cB + hstep, voffB); PG8_STAGE(PG8_SA(0, 1), cA + hstep, voffA);
        if (wr == 1) PG8_BAR;
        PG8_WAIT_V(4); PG8_BAR;
        PG8_STAGE(PG8_SB(1, 0), cB + kstep, voffB); PG8_STAGE(PG8_SA(1, 0), cA + kstep, voffA); PG8_STAGE(PG8_SB(1, 1), cB + hstep + kstep, voffB);
        PG8_WAIT_V(6); PG8_BAR;
    }
    for (;;) {
        const bool has_next = S.next(ui + 1, nxt);
        const char* nA = has_next ? (const char*)g.A + (size_t)nxt.pm * tstep : cA; const char* nB = has_next ? (const char*)g.Bt + (size_t)nxt.pn * tstep : cB;
        for (int t = 0; t < nt; t += 2) {
            const bool last = (t == nt - 2);
            const char* a1 = cA + (size_t)(t + 1) * kstep;
            const char* a2 = last ? nA : cA + (size_t)(t + 2) * kstep; const char* b2 = last ? nB : cB + (size_t)(t + 2) * kstep;
            const char* a3 = a2 + kstep; const char* b3 = b2 + kstep;
            if (last && has_next) S.a_ready(nxt);
            if constexpr (SP2) {
            PG8_LDB(B0, 0, 0); PG8_LDB(B1, 0, 1); PG8_SCHED; PG8_LDA(At, 0, 0); PG8_STAGE(PG8_SA(1, 1), a1 + hstep, voffA);
            PG8_WAIT_V(8); PG8_WAIT_L(0); PG8_BAR; PG8_MMA(0, 0, At, B0); PG8_MMA(0, 1, At, B1); PG8_BAR; PG8_SCHED;
            PG8_LDA(At, 0, 1); PG8_STAGE(PG8_SB(0, 0), b2, voffB); PG8_STAGE(PG8_SB(0, 1), b2 + hstep, voffB); PG8_STAGE(PG8_SA(0, 0), a2, voffA);
            PG8_WAIT_V(8); PG8_WAIT_L(0); PG8_BAR; PG8_MMA(1, 0, At, B0); PG8_MMA(1, 1, At, B1); PG8_BAR; PG8_SCHED;
            PG8_LDB(B0, 1, 0); PG8_LDB(B1, 1, 1); PG8_SCHED; PG8_LDA(At, 1, 0); PG8_STAGE(PG8_SA(0, 1), a2 + hstep, voffA);
            PG8_WAIT_V(8); PG8_WAIT_L(0); PG8_BAR; PG8_MMA(0, 0, At, B0); PG8_MMA(0, 1, At, B1); PG8_BAR; PG8_SCHED;
            PG8_LDA(At, 1, 1); PG8_STAGE(PG8_SB(1, 0), b3, voffB); PG8_STAGE(PG8_SB(1, 1), b3 + hstep, voffB); PG8_STAGE(PG8_SA(1, 0), a3, voffA);
            PG8_WAIT_V(8); PG8_WAIT_L(0); PG8_BAR; PG8_MMA(1, 0, At, B0); PG8_MMA(1, 1, At, B1); PG8_BAR; PG8_SCHED;
            } else {
            PG8_LDB(B0, 0, 0); PG8_SCHED; PG8_LDA(At, 0, 0); PG8_STAGE(PG8_SA(1, 1), a1 + hstep, voffA);
            PG8_WAIT_L(8); PG8_BAR; PG8_WAIT_L(0); PG8_MMA(0, 0, At, B0); PG8_BAR; PG8_SCHED;
            PG8_LDB(B1, 0, 1); PG8_STAGE(PG8_SB(0, 0), b2, voffB);
            PG8_BAR; PG8_WAIT_L(0); PG8_MMA(0, 1, At, B1); PG8_BAR;
            PG8_LDA(At, 0, 1); PG8_STAGE(PG8_SA(0, 0), a2, voffA);
            PG8_BAR; PG8_WAIT_L(0); PG8_MMA(1, 0, At, B0); PG8_BAR; PG8_SCHED;
            PG8_STAGE(PG8_SB(0, 1), b2 + hstep, voffB);
            PG8_WAIT_V(6); PG8_BAR; PG8_MMA(1, 1, At, B1); PG8_BAR;
            PG8_LDB(B0, 1, 0); PG8_SCHED; PG8_LDA(At, 1, 0); PG8_STAGE(PG8_SA(0, 1), a2 + hstep, voffA);
            PG8_WAIT_L(8); PG8_BAR; PG8_WAIT_L(0); PG8_MMA(0, 0, At, B0); PG8_BAR; PG8_SCHED;
            PG8_LDB(B1, 1, 1); PG8_STAGE(PG8_SB(1, 0), b3, voffB);
            PG8_BAR; PG8_WAIT_L(0); PG8_MMA(0, 1, At, B1); PG8_BAR;
            PG8_LDA(At, 1, 1); PG8_STAGE(PG8_SA(1, 0), a3, voffA);
            PG8_BAR; PG8_WAIT_L(0); PG8_MMA(1, 0, At, B0); PG8_BAR; PG8_SCHED;
            PG8_STAGE(PG8_SB(1, 1), b3 + hstep, voffB);
            PG8_WAIT_V(6); PG8_BAR; PG8_MMA(1, 1, At, B1); PG8_BAR;
            }
        }
        if constexpr (ALIGN_EPI) { if (wr == 0) PG8_BAR; }
        if constexpr (!Epi::AFTER_DRAIN) { E(acc, cur, wr, wc, fr, fq); S.done(cur); }
        if (!has_next) break;
#pragma unroll
        for (int a = 0; a < 2; ++a)
#pragma unroll
            for (int b = 0; b < 2; ++b)
#pragma unroll
                for (int m = 0; m < 4; ++m)
#pragma unroll
                    for (int n = 0; n < 2; ++n) acc[a][b][m][n] = (f32x4){0.f, 0.f, 0.f, 0.f};
        cur = nxt; cA = nA; cB = nB; ++ui;
        if constexpr (ALIGN_EPI) { if (wr == 1) PG8_BAR; }
    }
    PG8_WAIT_V(0);
    if constexpr (!ALIGN_EPI) { if (wr == 0) PG8_BAR; }
    PG8_BAR;
    if constexpr (Epi::AFTER_DRAIN) { E.fused(acc, cur, wr, wc, fr, fq, lds, wid, lane); S.done(cur); }
#undef PG8_SA
#undef PG8_SB
#undef PG8_STAGE
#undef PG8_LDA
#undef PG8_LDB
#undef PG8_MMA
#undef PG8_WAIT_V
#undef PG8_WAIT_L
#undef PG8_BAR
#undef PG8_SCHED
}
}

#define LAS __attribute__((address_space(3)))
typedef unsigned short bf16;
typedef unsigned v4u __attribute__((ext_vector_type(4)));
typedef unsigned v2u __attribute__((ext_vector_type(2)));
typedef float f32x4 __attribute__((ext_vector_type(4)));
typedef float f32x16 __attribute__((ext_vector_type(16)));
typedef short bf16x8 __attribute__((ext_vector_type(8)));
using pg8::cvt_pk_bf16;

constexpr int NWAVES = 8;
constexpr int BATCH = 8, SEQ = 4096, D = 1024, FF = 4096, M = BATCH * SEQ;
constexpr size_t MiB = 1u << 20;
constexpr size_t WS_SSQ = 0;
constexpr size_t WS_BAR = 1280 * 1024;
constexpr size_t WS_TAB = 1536 * 1024;
constexpr size_t WS_WA_QKV = 2 * MiB, WS_WA_O = 8 * MiB, WA_STRIDE = 8 * MiB;
constexpr size_t WS_WB_Q0 = 18 * MiB;
constexpr size_t WS_WB_Q1 = 21 * MiB;
constexpr size_t WS_WB_O = 23 * MiB;
constexpr size_t WS_WUP = 27 * MiB, WS_WDN = 35 * MiB, WM_STRIDE = 16 * MiB;
constexpr size_t WS_HB = 92 * MiB;
constexpr size_t WS_KSH = 156 * MiB, WS_VTSH = 164 * MiB;
constexpr size_t WS_BIG = 172 * MiB;
constexpr size_t WS_END = 428 * MiB;
constexpr int LDS_BYTES = 147456;

__device__ __forceinline__ float wave_sum(float v) {
#pragma unroll
    for (int o = 1; o < 64; o <<= 1) v += __shfl_xor(v, o);
    return v;
}
typedef float f32x2_t __attribute__((ext_vector_type(2))); typedef __bf16 bf16x2_t __attribute__((ext_vector_type(2)));
__device__ __forceinline__ unsigned pk2(float lo, float hi) { f32x2_t v = {lo, hi}; bf16x2_t b = __builtin_convertvector(v, bf16x2_t); return __builtin_bit_cast(unsigned, b); }

__device__ __forceinline__ void transpose_item(const float* W, const float* gain, int K, int N, bf16* WT, int row_off, LAS float* scr, int item, int lane) {
    const int nblk = N / 32, kb = item / nblk, nb = item % nblk, k0 = 64 * kb, n0 = 32 * nb;
#pragma unroll 8
    for (int i = 0; i < 32; ++i) { const int kk = 2 * i + (lane >> 5); const float g = gain ? gain[k0 + kk] : 1.0f; scr[kk * 33 + (lane & 31)] = W[(size_t)(k0 + kk) * N + n0 + (lane & 31)] * g; }
    asm volatile("s_waitcnt lgkmcnt(0)" ::: "memory");
    const int c = lane & 7;
#pragma unroll
    for (int j = 0; j < 4; ++j) { const int n = (lane >> 3) + 8 * j; const LAS float* s = scr + (8 * c) * 33 + n;
        v4u o; o.x = pk2(s[0 * 33], s[1 * 33]); o.y = pk2(s[2 * 33], s[3 * 33]); o.z = pk2(s[4 * 33], s[5 * 33]); o.w = pk2(s[6 * 33], s[7 * 33]);
        *(v4u*)(WT + (size_t)(row_off + n0 + n) * K + k0 + 8 * c) = o; }
    asm volatile("s_waitcnt lgkmcnt(0)" ::: "memory");
}

__device__ __forceinline__ int pi32(int m) { return (m & ~12) | ((m & 4) << 1) | ((m & 8) >> 1); }
#define MFMA32(a, b, c) __builtin_amdgcn_mfma_f32_32x32x16_bf16((a), (b), (c), 0, 0, 0)
constexpr float LOG2E = 1.4426950408889634f, LN2 = 0.6931471805599453f;

__device__ __forceinline__ void sb_attn_phase(const bf16* Q, const bf16* K, const bf16* VT, bf16* O, int gw, int ngw, int lane_in) {
    int lane = lane_in; asm volatile("" : "+v"(lane));
    const int ql = lane & 31, hi = lane >> 5, kperm = pi32(ql);
    for (int unit = gw; unit < BATCH * 16 * (SEQ / 32); unit += ngw) {
        const int qt = unit & 127, bh = unit >> 7, h = bh & 15, b = bh >> 4, q0 = qt * 32, t = q0 + ql;
        const size_t tok0 = (size_t)b * SEQ;
        const bf16* qp = Q + (tok0 + q0 + ql) * D + h * 64 + 8 * hi;
        bf16x8 qf[4];
#pragma unroll
        for (int kk = 0; kk < 4; ++kk) qf[kk] = *(const bf16x8*)(qp + 16 * kk);
        f32x16 o0, o1;
#pragma unroll
        for (int r = 0; r < 16; ++r) { o0[r] = 0.f; o1[r] = 0.f; }
        float carry = 0.f;
        const bf16* kbase = K + tok0 * D + h * 64 + 8 * hi;
        const bf16* vbase = VT + ((size_t)(b * D + h * 64 + ql)) * SEQ + 8 * hi;
        for (int jb = q0 >> 6; jb >= 0; --jb) {
            const int k0 = jb * 64;
            bf16x8 kf[2][4], vf[2][4];
#pragma unroll
            for (int hf = 0; hf < 2; ++hf)
#pragma unroll
                for (int kk = 0; kk < 4; ++kk) kf[hf][kk] = *(const bf16x8*)(kbase + (size_t)(k0 + 32 * hf + kperm) * D + 16 * kk);
#pragma unroll
            for (int dh = 0; dh < 2; ++dh)
#pragma unroll
                for (int c = 0; c < 4; ++c) vf[dh][c] = *(const bf16x8*)(vbase + (size_t)(32 * dh) * SEQ + k0 + 16 * c);
            f32x16 p0, p1;
#pragma unroll
            for (int r = 0; r < 16; ++r) { p0[r] = 0.f; p1[r] = 0.f; }
#pragma unroll
            for (int kk = 0; kk < 4; ++kk) { p0 = MFMA32(kf[0][kk], qf[kk], p0); p1 = MFMA32(kf[1][kk], qf[kk], p1); }
            float L[4][8], ls[4][8], cs[4], pcs[4];
#pragma unroll
            for (int c = 0; c < 4; ++c) { float acc = 0.f;
#pragma unroll
                for (int i = 0; i < 8; ++i) {
                    const float z = ((c < 2) ? p0[8 * (c & 1) + i] : p1[8 * (c & 1) + i]) * 0.125f;
                    const bool valid = (k0 + 16 * c + 8 * hi + i) < t;
                    const float e = __builtin_amdgcn_exp2f(-fabsf(z) * LOG2E);
                    const float sp = __builtin_amdgcn_logf(1.0f + e) * LN2;
                    L[c][i] = valid ? -(fmaxf(z, 0.f) + sp) : 0.f;
                    ls[c][i] = valid ? (fminf(z, 0.f) - sp) : -1e30f;
                    acc += L[c][i]; }
                cs[c] = acc; }
#pragma unroll
            for (int c = 0; c < 4; ++c) pcs[c] = __shfl_xor(cs[c], 32);
            float run = carry;
            bf16x8 wf[4];
#pragma unroll
            for (int c = 3; c >= 0; --c) {
                float r_ = run + (hi == 0 ? pcs[c] : 0.f);
                float w[8];
#pragma unroll
                for (int i = 7; i >= 0; --i) { w[i] = __builtin_amdgcn_exp2f((ls[c][i] + r_) * LOG2E); r_ += L[c][i]; }
                v4u pk; pk.x = pk2(w[0], w[1]); pk.y = pk2(w[2], w[3]); pk.z = pk2(w[4], w[5]); pk.w = pk2(w[6], w[7]);
                wf[c] = __builtin_bit_cast(bf16x8, pk);
                run += cs[c] + pcs[c]; }
            carry = run;
#pragma unroll
            for (int c = 0; c < 4; ++c) { o0 = MFMA32(vf[0][c], wf[c], o0); o1 = MFMA32(vf[1][c], wf[c], o1); }
            if (__all(carry < -104.0f)) break;
        }
        bf16* op = O + (tok0 + q0 + ql) * D + h * 64 + 4 * hi;
#pragma unroll
        for (int g = 0; g < 4; ++g) {
            v2u a; a.x = pk2(o0[4 * g], o0[4 * g + 1]); a.y = pk2(o0[4 * g + 2], o0[4 * g + 3]); *(v2u*)(op + 8 * g) = a;
            v2u c; c.x = pk2(o1[4 * g], o1[4 * g + 1]); c.y = pk2(o1[4 * g + 2], o1[4 * g + 3]); *(v2u*)(op + 32 + 8 * g) = c; }
    }
}

__device__ __forceinline__ void swa_attn_phase(const bf16* Q, const bf16* Ksh, const bf16* VTsh, bf16* O, const float* sinks, const LAS float* tab, int gw, int ngw, int lane_in) {
    int lane = lane_in; asm volatile("" : "+v"(lane));
    const int ql = lane & 31, hi = lane >> 5, kperm = pi32(ql);
    for (int unit = gw; unit < BATCH * 16 * (SEQ / 32); unit += ngw) {
        const int qt = unit & 127, bh = unit >> 7, qh = bh & 15, b = bh >> 4, kvh = qh >> 3, q0 = qt * 32, t = q0 + ql;
        const size_t tok0 = (size_t)b * SEQ;
        const bf16* qp = Q + (tok0 + q0 + ql) * D + qh * 64 + 8 * hi;
        bf16x8 qf[4];
#pragma unroll
        for (int kk = 0; kk < 4; ++kk) qf[kk] = *(const bf16x8*)(qp + 16 * kk);
        const float sink = sinks[qh];
        const LAS float* tb = tab + qh * 128;
        f32x16 p[5];
        float mx = sink;
#pragma unroll
        for (int j = 0; j < 5; ++j) {
            const int k0 = q0 - 128 + 32 * j;
#pragma unroll
            for (int r = 0; r < 16; ++r) p[j][r] = 0.f;
            if (k0 >= 0) {
                const bf16* kp = Ksh + (tok0 + k0 + kperm) * 128 + kvh * 64 + 8 * hi;
#pragma unroll
                for (int kk = 0; kk < 4; ++kk) { const bf16x8 kf = *(const bf16x8*)(kp + 16 * kk); p[j] = MFMA32(kf, qf[kk], p[j]); }
            }
#pragma unroll
            for (int r = 0; r < 16; ++r) {
                const int dist = t - (k0 + 16 * (r >> 3) + 8 * hi + (r & 7));
                const bool valid = (k0 >= 0) && dist >= 0 && dist < 128;
                const float s = valid ? (p[j][r] * 0.125f + tb[dist & 127]) : -1e30f;
                p[j][r] = s; mx = fmaxf(mx, s); }
        }
        mx = fmaxf(mx, __shfl_xor(mx, 32));
        float sum = 0.f;
        bf16x8 pf[5][2];
#pragma unroll
        for (int j = 0; j < 5; ++j) {
            float e[16];
#pragma unroll
            for (int r = 0; r < 16; ++r) { e[r] = __builtin_amdgcn_exp2f((p[j][r] - mx) * LOG2E); sum += e[r]; }
#pragma unroll
            for (int a = 0; a < 2; ++a) { v4u pk; pk.x = pk2(e[8 * a], e[8 * a + 1]); pk.y = pk2(e[8 * a + 2], e[8 * a + 3]); pk.z = pk2(e[8 * a + 4], e[8 * a + 5]); pk.w = pk2(e[8 * a + 6], e[8 * a + 7]);
                pf[j][a] = __builtin_bit_cast(bf16x8, pk); }
        }
        sum += __shfl_xor(sum, 32);
        sum += __builtin_amdgcn_exp2f((sink - mx) * LOG2E);
        const float inv = 1.0f / sum;
        f32x16 o0, o1;
#pragma unroll
        for (int r = 0; r < 16; ++r) { o0[r] = 0.f; o1[r] = 0.f; }
        const bf16* vbase = VTsh + ((size_t)(b * 128 + kvh * 64 + ql)) * SEQ + 8 * hi;
#pragma unroll
        for (int j = 0; j < 5; ++j) {
            const int k0 = q0 - 128 + 32 * j;
            if (k0 >= 0) {
#pragma unroll
                for (int a = 0; a < 2; ++a) {
                    const bf16x8 v0 = *(const bf16x8*)(vbase + k0 + 16 * a);
                    const bf16x8 v1 = *(const bf16x8*)(vbase + (size_t)32 * SEQ + k0 + 16 * a);
                    o0 = MFMA32(v0, pf[j][a], o0); o1 = MFMA32(v1, pf[j][a], o1); }
            }
        }
        bf16* op = O + (tok0 + q0 + ql) * D + qh * 64 + 4 * hi;
#pragma unroll
        for (int g = 0; g < 4; ++g) {
            v2u a; a.x = pk2(o0[4 * g] * inv, o0[4 * g + 1] * inv); a.y = pk2(o0[4 * g + 2] * inv, o0[4 * g + 3] * inv); *(v2u*)(op + 8 * g) = a;
            v2u c; c.x = pk2(o1[4 * g] * inv, o1[4 * g + 1] * inv); c.y = pk2(o1[4 * g + 2] * inv, o1[4 * g + 3] * inv); *(v2u*)(op + 32 + 8 * g) = c; }
    }
}


__device__ __forceinline__ float bf2f(bf16 v) { return __uint_as_float((unsigned)v << 16); }
__device__ __forceinline__ void sb_attn_naive(const bf16* Q, const bf16* K, const bf16* VT, bf16* O, int gtid_in, int gthreads) {
    int gtid = gtid_in; asm volatile("" : "+v"(gtid));
    for (int idx = gtid; idx < BATCH * 16 * SEQ; idx += gthreads) {
        const int t = idx & 4095, bh = idx >> 12, h = bh & 15, b = bh >> 4;
        const size_t tok0 = (size_t)b * SEQ;
        float o[64]; const bf16* q = Q + (tok0 + t) * D + h * 64;
#pragma unroll
        for (int d = 0; d < 64; ++d) o[d] = 0.f;
        float carry = 0.f;
        for (int s = t - 1; s >= 0; --s) {
            float z = 0.f;
#pragma unroll
            for (int d = 0; d < 64; ++d) z += bf2f(q[d]) * bf2f(K[(tok0 + s) * D + h * 64 + d]);
            z *= 0.125f;
            const float sp = __builtin_amdgcn_logf(1.0f + __builtin_amdgcn_exp2f(-fabsf(z) * 1.4426950408889634f)) * 0.6931471805599453f;
            const float w = __builtin_amdgcn_exp2f((fminf(z, 0.f) - sp + carry) * 1.4426950408889634f);
            carry += -(fmaxf(z, 0.f) + sp);
#pragma unroll
            for (int d = 0; d < 64; ++d) o[d] += w * bf2f(VT[((size_t)(b * D + h * 64 + d)) * SEQ + s]);
            if (carry < -104.f) break;
        }
#pragma unroll
        for (int d = 0; d < 64; ++d) O[(tok0 + t) * D + h * 64 + d] = pg8::bf1(o[d]);
    }
}
__device__ __forceinline__ void swa_attn_naive(const bf16* Q, const bf16* Ksh, const bf16* VTsh, bf16* O, const float* sinks, const float* tabg, int gtid_in, int gthreads) {
    int gtid = gtid_in; asm volatile("" : "+v"(gtid));
    for (int idx = gtid; idx < BATCH * 16 * SEQ; idx += gthreads) {
        const int t = idx & 4095, bh = idx >> 12, qh = bh & 15, b = bh >> 4, kvh = qh >> 3;
        const size_t tok0 = (size_t)b * SEQ;
        float o[64]; const bf16* q = Q + (tok0 + t) * D + qh * 64;
#pragma unroll
        for (int d = 0; d < 64; ++d) o[d] = 0.f;
        const float sink = sinks[qh];
        float mx = sink, sum = 0.f;
        const int s_lo = t - 127 > 0 ? t - 127 : 0;
        for (int s = s_lo; s <= t; ++s) {
            float z = 0.f;
#pragma unroll
            for (int d = 0; d < 64; ++d) z += bf2f(q[d]) * bf2f(Ksh[(tok0 + s) * 128 + kvh * 64 + d]);
            z = z * 0.125f + tabg[qh * 128 + (t - s)];
            const float nm = fmaxf(mx, z), sc = __builtin_amdgcn_exp2f((mx - nm) * 1.4426950408889634f), e = __builtin_amdgcn_exp2f((z - nm) * 1.4426950408889634f);
            sum = sum * sc + e; mx = nm;
#pragma unroll
            for (int d = 0; d < 64; ++d) o[d] = o[d] * sc + e * bf2f(VTsh[((size_t)(b * 128 + kvh * 64 + d)) * SEQ + s]);
        }
        sum += __builtin_amdgcn_exp2f((sink - mx) * 1.4426950408889634f);
        const float inv = 1.0f / sum;
#pragma unroll
        for (int d = 0; d < 64; ++d) O[(tok0 + t) * D + qh * 64 + d] = pg8::bf1(o[d] * inv);
    }
}
#define XB_TMO      128
#define XB_XCNT(j)  (256  + 64 * (j))
#define XB_XSUB(j)  (1280 + 64 * (j))
#define XB_XGEN(j)  (2304 + 64 * (j))
#define XB_TOP      3328
#define XB_TOPGEN   3392
#define XCD_BAR_WORDS 3456
#define XB_SPIN_CAP (1u << 18)

__device__ __forceinline__ unsigned xb_ld(unsigned* p)              { return __hip_atomic_load(p, __ATOMIC_RELAXED, __HIP_MEMORY_SCOPE_AGENT); }
__device__ __forceinline__ unsigned xb_add(unsigned* p, unsigned v) { return __hip_atomic_fetch_add(p, v, __ATOMIC_RELAXED, __HIP_MEMORY_SCOPE_AGENT); }
__device__ __forceinline__ unsigned xb_xcc_id() { return (unsigned)__builtin_amdgcn_s_getreg((3 << 11) | 20) & 0xFu; }
#define XB_SPIN(cond, bar) do { unsigned _sp = 0; while (cond) { __builtin_amdgcn_s_sleep(1); \
    if ((++_sp & 255u) == 0u) { if (xb_ld(&(bar)[XB_TMO])) break; if (_sp > XB_SPIN_CAP) { atomicAdd(&(bar)[XB_TMO], 1u); break; } } } } while (0)

struct XcdBarrier {
    unsigned* bar; unsigned x;
    volatile LAS unsigned* st;
};

__device__ __forceinline__ XcdBarrier xcd_barrier_post(unsigned* bar, volatile LAS unsigned* st) {
    XcdBarrier b; b.bar = bar; b.x = xb_xcc_id(); b.st = st;
    if (threadIdx.x == 0) (void)xb_add(&bar[XB_XCNT(b.x)], 1u);
    return b;
}
__device__ __forceinline__ void xcd_barrier_complete(unsigned* bar, unsigned x, unsigned& nloc, unsigned& nx) {
    const unsigned G = gridDim.x * gridDim.y * gridDim.z;
    unsigned sum, cnt, mine, sp = 0u;
    for (;;) {
        sum = 0u; cnt = 0u; mine = 0u;
#pragma unroll
        for (unsigned j = 0; j < 16; ++j) { const unsigned c = xb_ld(&bar[XB_XCNT(j)]); sum += c; cnt += (c > 0u) ? 1u : 0u; mine = (j == x) ? c : mine; }
        if (sum == G) break;
        __builtin_amdgcn_s_sleep(1);
        if ((++sp & 255u) == 0u) { if (xb_ld(&bar[XB_TMO])) break; if (sp > XB_SPIN_CAP) { atomicAdd(&bar[XB_TMO], 1u); break; } }
    }
    nloc = mine > 0u ? mine : 1u; nx = cnt > 0u ? cnt : 1u;
}

__device__ __forceinline__ void xcd_barrier(const XcdBarrier& b) {
    asm volatile("s_waitcnt vmcnt(0)" ::: "memory");
    __syncthreads();
    if (threadIdx.x == 0) {
        unsigned* bar = b.bar;
        __builtin_amdgcn_s_waitcnt(0);
        unsigned nloc = b.st[0], nx = b.st[1];
        if (nloc == 0u) { xcd_barrier_complete(bar, b.x, nloc, nx); b.st[0] = nloc; b.st[1] = nx; }
        const unsigned old = xb_add(&bar[XB_XSUB(b.x)], 1u);
        const unsigned gen = old / nloc;
        if (old + 1u == (gen + 1u) * nloc) {
            __builtin_amdgcn_fence(__ATOMIC_RELEASE, "agent");
            asm volatile("s_waitcnt vmcnt(0)" ::: "memory");
            const unsigned og = xb_add(&bar[XB_TOP], 1u);
            const unsigned tg = og / nx;
            if (og + 1u == (tg + 1u) * nx) xb_add(&bar[XB_TOPGEN], 1u);
            else XB_SPIN(xb_ld(&bar[XB_TOPGEN]) == tg, bar);
            __builtin_amdgcn_fence(__ATOMIC_ACQUIRE, "agent");
            xb_add(&bar[XB_XGEN(b.x)], 1u);
            asm volatile("s_waitcnt vmcnt(0)" ::: "memory");
        } else {
            XB_SPIN(xb_ld(&bar[XB_XGEN(b.x)]) == gen, bar);
            __builtin_amdgcn_fence(__ATOMIC_ACQUIRE, "agent");
            asm volatile("s_waitcnt vmcnt(0)" ::: "memory");
        }
    }
    __syncthreads();
}

#ifndef REP_SB
#define REP_SB 1
#endif
#ifndef REP_SWA
#define REP_SWA 1
#endif
#ifndef REP_UP
#define REP_UP 1
#endif
#ifndef EXTRA_SYNC
#define EXTRA_SYNC 0
#endif
#ifndef ONLY
#define ONLY -1
#endif
#define PH(n) (ONLY < 0 || ONLY == (n))
struct Args { const float* in[18]; float* out; unsigned char* ws; };

__global__ void __launch_bounds__(NWAVES * 64, 2) yoco_fwd(Args args) {
    extern __shared__ __attribute__((aligned(16))) unsigned char lds_raw[];
    cg::grid_group grid = cg::this_grid();
    LAS unsigned char* lds = (LAS unsigned char*)lds_raw;
    const int tid = threadIdx.x, lane = tid & 63, wave = __builtin_amdgcn_readfirstlane(tid >> 6);
    const int G = gridDim.x, bx = blockIdx.x;
    const int vcu = (G % 8 == 0) ? (bx % 8) * (G / 8) + bx / 8 : bx;
    const int gw = vcu * NWAVES + wave, NGW = G * NWAVES;
    volatile LAS unsigned long long* slots = (volatile LAS unsigned long long*)(lds + 131072 + 2048);
    if (tid == 0) {
#pragma unroll
        for (int i = 0; i < 18; ++i) slots[i] = (unsigned long long)args.in[i];
        slots[18] = (unsigned long long)args.out; slots[19] = (unsigned long long)args.ws;
    }
    __syncthreads();
#define GP(i) ((const float*)(((unsigned long long)(unsigned)__builtin_amdgcn_readfirstlane((unsigned)(slots[i] >> 32)) << 32) | (unsigned long long)(unsigned)__builtin_amdgcn_readfirstlane((unsigned)slots[i])))
#define P_x GP(0)
#define P_a_norm GP(1)
#define P_a_wqkv GP(2)
#define P_a_wo GP(3)
#define P_kv_norm GP(4)
#define P_w_kv GP(5)
#define P_b_kv GP(6)
#define P_b_norm GP(7)
#define P_b_wq GP(8)
#define P_b_bq GP(9)
#define P_b_sinks GP(10)
#define P_b_wo GP(11)
#define P_b_bo GP(12)
#define P_rel_bias GP(13)
#define P_mlp_norm GP(14)
#define P_mlp_up GP(15)
#define P_mlp_down GP(16)
#define P_final_norm GP(17)
#define P_out ((float*)GP(18))
#define P_ws ((unsigned char*)GP(19))
#define P_ssq ((float*)(P_ws + WS_SSQ))
#define P_tabg ((float*)(P_ws + WS_TAB))
#define P_HB ((bf16*)(P_ws + WS_HB))
#define P_KSH ((bf16*)(P_ws + WS_KSH))
#define P_VTSH ((bf16*)(P_ws + WS_VTSH))
#define P_U ((bf16*)(P_ws + WS_BIG))
#define P_Qb ((bf16*)(P_ws + WS_BIG))
#define P_Kb ((bf16*)(P_ws + WS_BIG + 64 * MiB))
#define P_VTb ((bf16*)(P_ws + WS_BIG + 128 * MiB))
#define P_Ob ((bf16*)(P_ws + WS_BIG + 192 * MiB))

    if (PH(0)) {
        LAS float* scr = (LAS float*)(lds + wave * 16384);
        constexpr int I_QKV = (D / 64) * (3 * D / 32), I_DD = (D / 64) * (D / 32), I_KV = (D / 64) * (256 / 32), I_UP = (D / 64) * (FF / 32), I_DN = (FF / 64) * (D / 32);
        constexpr int NITEMS = 2 * (I_QKV + I_DD) + (I_DD + I_KV) + I_DD + 2 * I_DD + 4 * (I_UP + I_DN);
        for (int it = gw; it < NITEMS; it += NGW) {
            int r = it; bool done = false;
#pragma unroll
            for (int l = 0; l < 2; ++l) {
                if (!done && r < I_QKV) { transpose_item(P_a_wqkv + (size_t)l * D * 3 * D, P_a_norm + l * D, D, 3 * D, (bf16*)(P_ws + WS_WA_QKV + l * WA_STRIDE), 0, scr, r, lane); done = true; } if (!done) r -= I_QKV;
                if (!done && r < I_DD) { transpose_item(P_a_wo + (size_t)l * D * D, nullptr, D, D, (bf16*)(P_ws + WS_WA_O + l * WA_STRIDE), 0, scr, r, lane); done = true; } if (!done) r -= I_DD;
            }
            if (!done && r < I_DD) { transpose_item(P_b_wq, P_b_norm, D, D, (bf16*)(P_ws + WS_WB_Q0), 0, scr, r, lane); done = true; } if (!done) r -= I_DD;
            if (!done && r < I_KV) { transpose_item(P_w_kv, P_kv_norm, D, 256, (bf16*)(P_ws + WS_WB_Q0), 1024, scr, r, lane); done = true; } if (!done) r -= I_KV;
            if (!done && r < I_DD) { transpose_item(P_b_wq + (size_t)D * D, P_b_norm + D, D, D, (bf16*)(P_ws + WS_WB_Q1), 0, scr, r, lane); done = true; } if (!done) r -= I_DD;
#pragma unroll
            for (int j = 0; j < 2; ++j) { if (!done && r < I_DD) { transpose_item(P_b_wo + (size_t)j * D * D, nullptr, D, D, (bf16*)(P_ws + WS_WB_O + j * 2 * MiB), 0, scr, r, lane); done = true; } if (!done) r -= I_DD; }
#pragma unroll
            for (int l = 0; l < 4; ++l) {
                if (!done && r < I_UP) { transpose_item(P_mlp_up + (size_t)l * D * FF, P_mlp_norm + l * D, D, FF, (bf16*)(P_ws + WS_WUP + l * WM_STRIDE), 0, scr, r, lane); done = true; } if (!done) r -= I_UP;
                if (!done && r < I_DN) { transpose_item(P_mlp_down + (size_t)l * FF * D, nullptr, FF, D, (bf16*)(P_ws + WS_WDN + l * WM_STRIDE), 0, scr, r, lane); done = true; } if (!done) r -= I_DN;
            }
        }
        for (int m = gw; m < M; m += NGW) {
            const f32x4* xr = (const f32x4*)(P_x + (size_t)m * D) + lane; float s = 0.f;
            unsigned long long* o8 = (unsigned long long*)(P_HB + (size_t)m * D) + lane;
#pragma unroll
            for (int j = 0; j < 4; ++j) { const f32x4 v = xr[64 * j]; s += (v.x * v.x + v.y * v.y) + (v.z * v.z + v.w * v.w);
                o8[64 * j] = (unsigned long long)pk2(v.x, v.y) | ((unsigned long long)pk2(v.z, v.w) << 32); }
            s = wave_sum(s);
            if (lane == 0) P_ssq[m] = s;
        }
        for (int i = bx * (NWAVES * 64) + tid; i < 8 * M; i += G * NWAVES * 64) P_ssq[M + i] = 0.f;
        if (bx == 0) for (int i = tid; i < XCD_BAR_WORDS; i += NWAVES * 64) ((unsigned*)(P_ws + WS_BAR))[i] = 0u;
        for (int i = bx * (NWAVES * 64) + tid; i < 16 * 128; i += G * NWAVES * 64) {
            const int h = i >> 7, n = i & 127;
            int bucket = n;
            if (n >= 16) { const int lg = 16 + (int)(logf((float)n / 16.0f) / 2.0794415416798357f * 16.0f); bucket = lg < 31 ? lg : 31; }
            P_tabg[i] = P_rel_bias[bucket * 16 + h];
        }
    }
    grid.sync();
    volatile LAS unsigned* bst = (volatile LAS unsigned*)(lds + 131072 + 1024);
    if (tid < 2) bst[tid] = 0u;
    __syncthreads();
    XcdBarrier xbar = xcd_barrier_post((unsigned*)(P_ws + WS_BAR), bst);
#define GRID_BAR() xcd_barrier(xbar)

    for (int layer = 0; layer < 4; ++layer) {
        const float* ssq_in = P_ssq + (size_t)(2 * layer) * M;
        float* ssq_mid = P_ssq + (size_t)(2 * layer + 1) * M;
        float* ssq_out = P_ssq + (size_t)(2 * layer + 2) * M;
        const float* resid_in = layer == 0 ? P_x : P_out;
        if (layer < 2) {
            if (PH(1)) { pg8::Gemm g{P_HB, (const bf16*)(P_ws + WS_WA_QKV + layer * WA_STRIDE), M, 3 * D, D}; pg8::StaticOrder S; S.init(M, 3 * D, G, bx);
              pg8::EpiQKV E{P_Qb, P_Kb, P_VTb, ssq_in};
              pg8::gemm_phase<pg8::EpiQKV, pg8::StaticOrder, true, true>(lds, g, S, E); }
            GRID_BAR();
#ifdef NAIVE_SB
            if (PH(2)) sb_attn_naive(P_Qb, P_Kb, P_VTb, P_Ob, bx * 512 + tid, G * 512);
#else
            for (int rep = 0; rep < REP_SB; ++rep) if (PH(2)) sb_attn_phase(P_Qb, P_Kb, P_VTb, P_Ob, gw, NGW, lane);
#endif
            GRID_BAR();
            if (PH(3)) { pg8::Gemm g{P_Ob, (const bf16*)(P_ws + WS_WA_O + layer * WA_STRIDE), M, D, D}; pg8::StaticOrder S; S.init(M, D, G, bx);
              pg8::EpiResid E{resid_in, P_out, P_HB, nullptr, ssq_mid};
              pg8::gemm_phase<pg8::EpiResid, pg8::StaticOrder, true, true>(lds, g, S, E); }
            GRID_BAR();
        } else {
            const int j = layer - 2;
            if (PH(4)) { if (j == 0) { pg8::Gemm g{P_HB, (const bf16*)(P_ws + WS_WB_Q0), M, 1280, D}; pg8::StaticOrder S; S.init(M, 1280, G, bx);
              pg8::EpiQB<true> E{P_Qb, P_KSH, P_VTSH, P_b_bq, P_b_kv, ssq_in};
              pg8::gemm_phase<pg8::EpiQB<true>, pg8::StaticOrder, true, true>(lds, g, S, E); }
            else { pg8::Gemm g{P_HB, (const bf16*)(P_ws + WS_WB_Q1), M, D, D}; pg8::StaticOrder S; S.init(M, D, G, bx);
              pg8::EpiQB<false> E{P_Qb, P_KSH, P_VTSH, P_b_bq + D, P_b_kv, ssq_in};
              pg8::gemm_phase<pg8::EpiQB<false>, pg8::StaticOrder, true, true>(lds, g, S, E); } }
            { LAS float* tab = (LAS float*)lds; for (int i = tid; i < 16 * 128; i += NWAVES * 64) tab[i] = P_tabg[i]; }
            GRID_BAR();
#ifdef NAIVE_SWA
            if (PH(5)) swa_attn_naive(P_Qb, P_KSH, P_VTSH, P_Ob, P_b_sinks + j * 16, P_tabg, bx * 512 + tid, G * 512);
#else
            for (int rep = 0; rep < REP_SWA; ++rep) if (PH(5)) swa_attn_phase(P_Qb, P_KSH, P_VTSH, P_Ob, P_b_sinks + j * 16, (const LAS float*)lds, gw, NGW, lane);
#endif
            GRID_BAR();
            if (PH(3)) { pg8::Gemm g{P_Ob, (const bf16*)(P_ws + WS_WB_O + j * 2 * MiB), M, D, D}; pg8::StaticOrder S; S.init(M, D, G, bx);
              pg8::EpiResid E{resid_in, P_out, P_HB, P_b_bo + j * D, ssq_mid};
              pg8::gemm_phase<pg8::EpiResid, pg8::StaticOrder, true, true>(lds, g, S, E); }
            GRID_BAR();
        }
        for (int rep = 0; rep < REP_UP; ++rep) if (PH(6)) { pg8::Gemm g{P_HB, (const bf16*)(P_ws + WS_WUP + layer * WM_STRIDE), M, FF, D}; pg8::StaticOrder S; S.init(M, FF, G, bx);
          pg8::EpiUp E{P_U, ssq_mid};
          pg8::gemm_phase<pg8::EpiUp, pg8::StaticOrder, true, true>(lds, g, S, E); }
        for (int rep = 0; rep < EXTRA_SYNC; ++rep) GRID_BAR();
        GRID_BAR();
        if (PH(7)) { pg8::Gemm g{P_U, (const bf16*)(P_ws + WS_WDN + layer * WM_STRIDE), M, D, FF}; pg8::StaticOrder S; S.init(M, D, G, bx);
          pg8::EpiResid E{P_out, P_out, P_HB, nullptr, ssq_out};
          pg8::gemm_phase<pg8::EpiResid, pg8::StaticOrder, true, true>(lds, g, S, E); }
        GRID_BAR();
    }
    if (PH(8)) {
        const float* ssq_fin = P_ssq + (size_t)8 * M;
        f32x4 gv[4];
#pragma unroll
        for (int j = 0; j < 4; ++j) gv[j] = ((const f32x4*)P_final_norm)[lane + 64 * j];
        for (int m = gw; m < M; m += NGW) {
            f32x4* xr = (f32x4*)(P_out + (size_t)m * D) + lane; const float rs = pg8::rstd_of(ssq_fin[m]);
#pragma unroll
            for (int j = 0; j < 4; ++j) { f32x4 v = xr[64 * j]; v = v * rs * gv[j]; xr[64 * j] = v; }
        }
    }
}

extern "C" void kernel_launch(void* const* d_in, const int* in_sizes, int n_in, void* d_out, int out_size, void* d_ws, size_t ws_size, hipStream_t stream) {
    static int grid = 0;
    if (grid == 0) {
        if (n_in != 18 || out_size != M * D || ws_size < WS_END) { fprintf(stderr, "kernel_launch: unexpected shapes (n_in %d, out %d, ws %zu)\n", n_in, out_size, ws_size); grid = -1; return; }
        int dev = 0, cus = 0, per_cu = 0;
        hipGetDevice(&dev);
        hipDeviceGetAttribute(&cus, hipDeviceAttributeMultiprocessorCount, dev);
        if (hipFuncSetAttribute((const void*)yoco_fwd, hipFuncAttributeMaxDynamicSharedMemorySize, LDS_BYTES) != hipSuccess) { fprintf(stderr, "kernel_launch: hipFuncSetAttribute failed\n"); grid = -1; return; }
        if (hipOccupancyMaxActiveBlocksPerMultiprocessor(&per_cu, (const void*)yoco_fwd, NWAVES * 64, LDS_BYTES) != hipSuccess || per_cu < 1) { fprintf(stderr, "kernel_launch: occupancy query failed (%d)\n", per_cu); per_cu = 1; }
        (void)hipGetLastError();
        grid = cus * per_cu;
        fprintf(stderr, "kernel_launch: grid %d (cus %d x %d)\n", grid, cus, per_cu);
    }
    if (grid < 0) return;
    Args a{};
    for (int i = 0; i < 18; ++i) a.in[i] = (const float*)d_in[i];
    a.out = (float*)d_out; a.ws = (unsigned char*)d_ws;
    void* kargs[] = {&a};
    hipError_t e = hipLaunchCooperativeKernel((const void*)yoco_fwd, dim3(grid), dim3(NWAVES * 64), kargs, LDS_BYTES, stream);
    if (e != hipSuccess) fprintf(stderr, "kernel_launch: cooperative launch failed: %s (grid %d)\n", hipGetErrorString(e), grid);
}
```

```cpp
#include <hip/hip_runtime.h>
#include <hip/hip_cooperative_groups.h>
#include <cstdio>
#include <cstdint>
namespace cg = cooperative_groups;
namespace pg8 {
#define PG8_LAS __attribute__((address_space(3)))
typedef unsigned short bf16_t;
typedef short bf16x8 __attribute__((ext_vector_type(8)));
typedef float f32x4 __attribute__((ext_vector_type(4)));
typedef unsigned u32x4 __attribute__((ext_vector_type(4)));
constexpr int BM = 256, BK = 64, HALF = 128, HTB = HALF * BK * 2  , STAGE_BYTES = 8 * HTB, NXCD = 8, WGM = 8;

__host__ __device__ __forceinline__ int lds_byte(int r, int c) { const int st = (r >> 4) * 2 + (c >> 5), rr = r & 15, cc = c & 31, ob = rr * 64 + cc * 2; return st * 1024 + (ob ^ (((ob >> 9) & 1) << 5)); }
__host__ __device__ __forceinline__ void stage_rc(int b, int& R, int& C) { const int st = b / 1024, sb = b % 1024, swz = sb ^ (((sb >> 9) & 1) << 5); R = (st >> 1) * 16 + swz / 64; C = (st & 1) * 32 + (swz % 64) / 2; }
__host__ __device__ __forceinline__ int perm32(int rho) { const int n = rho >> 4, i = rho & 15; return 8 * (i >> 2) + 4 * n + (i & 3); }

struct Unit { int pm, pn; };
struct Gemm { const bf16_t* A; const bf16_t* Bt; int M, N, K; };

struct StaticOrder {
    int nM, nN, nwg, G, c;
    __host__ __device__ void init(int M, int N, int G_, int c_) { nM = M / BM; nN = N / BM; nwg = nM * nN; G = G_; c = c_; }
    __host__ __device__ bool next(int i, Unit& u) const {
        const long L = (long)i * G + c; if (L >= nwg) return false;
        int wgid = (int)L; { const int q = nwg / NXCD, r = nwg % NXCD, xcd = wgid % NXCD, off = wgid / NXCD; wgid = (xcd < r ? xcd * (q + 1) : r * (q + 1) + (xcd - r) * q) + off; }
        const int nig = WGM * nN, gid = wgid / nig, fm = gid * WGM, gsz = (nM - fm) < WGM ? (nM - fm) : WGM;
        u.pm = fm + ((wgid % nig) % gsz); u.pn = (wgid % nig) / gsz; return true;
    }
    __device__ __forceinline__ void a_ready(const Unit&) const {}
    __device__ __forceinline__ void done(const Unit&) const {}
};

__device__ __forceinline__ unsigned cvt_pk_bf16(float lo, float hi) { unsigned r; asm volatile("v_cvt_pk_bf16_f32 %0, %1, %2" : "=v"(r) : "v"(lo), "v"(hi)); return r; }
typedef float f32x2 __attribute__((ext_vector_type(2)));
typedef unsigned u32x2 __attribute__((ext_vector_type(2)));
constexpr float RMS_EPS = 1e-5f;
constexpr int DM = 1024, SEQ = 4096, FF = 4096;
__device__ __forceinline__ float rstd_of(float ssq) { return 1.0f / sqrtf(ssq * (1.0f / 1024.0f) + RMS_EPS); }
__device__ __forceinline__ unsigned short bf1(float v) { return (unsigned short)(cvt_pk_bf16(v, 0.f) & 0xffffu); }

struct EpiQKV {
    static constexpr bool PERM = true, AFTER_DRAIN = false;
    bf16_t* Q; bf16_t* K; bf16_t* VT; const float* ssq;
    __device__ __forceinline__ void operator()(const f32x4 (&acc)[2][2][4][2], const Unit& u, int wr, int wc, int fr, int fq) const {
        const int row0 = u.pm * BM + wr * 64 + fr;
        const int t = u.pn >> 2, col0 = (u.pn & 3) * BM + wc * 32 + 8 * fq;
        if (t < 2) {
            bf16_t* base = t == 0 ? Q : K;
#pragma unroll
            for (int ai = 0; ai < 2; ++ai)
#pragma unroll
                for (int m = 0; m < 4; ++m) { const int row = row0 + ai * HALF + m * 16; const float rs = rstd_of(ssq[row]); bf16_t* rowp = base + (size_t)row * DM + col0;
#pragma unroll
                    for (int bj = 0; bj < 2; ++bj) { const f32x4 v0 = acc[ai][bj][m][0] * rs, v1 = acc[ai][bj][m][1] * rs; u32x4 w;
                        w.x = cvt_pk_bf16(v0[0], v0[1]); w.y = cvt_pk_bf16(v0[2], v0[3]); w.z = cvt_pk_bf16(v1[0], v1[1]); w.w = cvt_pk_bf16(v1[2], v1[3]);
                        *(u32x4*)(rowp + bj * HALF) = w; } }
        } else {
#pragma unroll
            for (int ai = 0; ai < 2; ++ai)
#pragma unroll
                for (int m = 0; m < 4; ++m) { asm volatile("" ::: "memory"); const int row = row0 + ai * HALF + m * 16; const float rs = rstd_of(ssq[row]); const int b = row >> 12, s = row & 4095;
                    bf16_t* cp = VT + ((size_t)(b * DM + col0)) * SEQ + s;
#pragma unroll
                    for (int bj = 0; bj < 2; ++bj)
#pragma unroll
                        for (int n = 0; n < 2; ++n)
#pragma unroll
                            for (int j = 0; j < 4; ++j) cp[(size_t)(bj * HALF + 4 * n + j) * SEQ] = bf1(acc[ai][bj][m][n][j] * rs); }
        }
    }
};

template <bool HAS_KV> struct EpiQB {
    static constexpr bool PERM = true, AFTER_DRAIN = false;
    bf16_t* Q; bf16_t* Ksh; bf16_t* VTsh; const float* bq; const float* bkv; const float* ssq;
    __device__ __forceinline__ void operator()(const f32x4 (&acc)[2][2][4][2], const Unit& u, int wr, int wc, int fr, int fq) const {
        const int row0 = u.pm * BM + wr * 64 + fr;
        if (!HAS_KV || u.pn < 4) {
            const int col0 = u.pn * BM + wc * 32 + 8 * fq;
#pragma unroll
            for (int ai = 0; ai < 2; ++ai)
#pragma unroll
                for (int m = 0; m < 4; ++m) { const int row = row0 + ai * HALF + m * 16; const float rs = rstd_of(ssq[row]); bf16_t* rowp = Q + (size_t)row * DM + col0;
#pragma unroll
                    for (int bj = 0; bj < 2; ++bj) { const f32x4 b0 = *(const f32x4*)(bq + col0 + bj * HALF), b1 = *(const f32x4*)(bq + col0 + bj * HALF + 4);
                        const f32x4 v0 = acc[ai][bj][m][0] * rs + b0, v1 = acc[ai][bj][m][1] * rs + b1; u32x4 w;
                        w.x = cvt_pk_bf16(v0[0], v0[1]); w.y = cvt_pk_bf16(v0[2], v0[3]); w.z = cvt_pk_bf16(v1[0], v1[1]); w.w = cvt_pk_bf16(v1[2], v1[3]);
                        *(u32x4*)(rowp + bj * HALF) = w; }
                    asm volatile("" ::: "memory"); }
        } else {
            const int c0 = wc * 32 + 8 * fq;
#pragma unroll
            for (int ai = 0; ai < 2; ++ai)
#pragma unroll
                for (int m = 0; m < 4; ++m) { const int row = row0 + ai * HALF + m * 16; const float rs = rstd_of(ssq[row]); const int b = row >> 12, s = row & 4095;
                    { const f32x4 b0 = *(const f32x4*)(bkv + c0), b1 = *(const f32x4*)(bkv + c0 + 4);
                      const f32x4 v0 = acc[ai][0][m][0] * rs + b0, v1 = acc[ai][0][m][1] * rs + b1; u32x4 w;
                      w.x = cvt_pk_bf16(v0[0], v0[1]); w.y = cvt_pk_bf16(v0[2], v0[3]); w.z = cvt_pk_bf16(v1[0], v1[1]); w.w = cvt_pk_bf16(v1[2], v1[3]);
                      *(u32x4*)(Ksh + (size_t)row * 128 + c0) = w; }
                    bf16_t* cp = VTsh + ((size_t)(b * 128 + c0)) * SEQ + s;
#pragma unroll
                    for (int n = 0; n < 2; ++n) { const f32x4 bb = *(const f32x4*)(bkv + 128 + c0 + 4 * n);
#pragma unroll
                        for (int j = 0; j < 4; ++j) cp[(size_t)(4 * n + j) * SEQ] = bf1(acc[ai][1][m][n][j] * rs + bb[j]); }
                    asm volatile("" ::: "memory"); }
        }
    }
};

struct EpiUp {
    static constexpr bool PERM = true, AFTER_DRAIN = false;
    bf16_t* U; const float* ssq;
    __device__ __forceinline__ void operator()(const f32x4 (&acc)[2][2][4][2], const Unit& u, int wr, int wc, int fr, int fq) const {
        const int row0 = u.pm * BM + wr * 64 + fr, col0 = u.pn * BM + wc * 32 + 8 * fq;
#pragma unroll
        for (int ai = 0; ai < 2; ++ai)
#pragma unroll
            for (int m = 0; m < 4; ++m) { const int row = row0 + ai * HALF + m * 16; const float rs = rstd_of(ssq[row]); bf16_t* rowp = U + (size_t)row * FF + col0;
#pragma unroll
                for (int bj = 0; bj < 2; ++bj) { f32x4 v0 = acc[ai][bj][m][0] * rs, v1 = acc[ai][bj][m][1] * rs;
#pragma unroll
                    for (int j = 0; j < 4; ++j) { const float a = fmaxf(v0[j], 0.f), b = fmaxf(v1[j], 0.f); v0[j] = a * a; v1[j] = b * b; }
                    u32x4 w; w.x = cvt_pk_bf16(v0[0], v0[1]); w.y = cvt_pk_bf16(v0[2], v0[3]); w.z = cvt_pk_bf16(v1[0], v1[1]); w.w = cvt_pk_bf16(v1[2], v1[3]);
                    *(u32x4*)(rowp + bj * HALF) = w; } }
    }
};

struct EpiResid {
    static constexpr bool PERM = false, AFTER_DRAIN = false;
    const float* base; float* out; bf16_t* hb; const float* bias; float* ssq_out;
    __device__ __forceinline__ void operator()(const f32x4 (&acc)[2][2][4][2], const Unit& u, int wr, int wc, int fr, int fq) const {
        const int row0 = u.pm * BM + wr * 64 + fr, col0 = u.pn * BM + wc * 32 + 4 * fq;
        f32x4 bv[2][2];
#pragma unroll
        for (int bj = 0; bj < 2; ++bj)
#pragma unroll
            for (int n = 0; n < 2; ++n) bv[bj][n] = bias ? *(const f32x4*)(bias + col0 + bj * HALF + n * 16) : (f32x4){0.f, 0.f, 0.f, 0.f};
#pragma unroll
        for (int ai = 0; ai < 2; ++ai)
#pragma unroll
            for (int m = 0; m < 4; ++m) { const int row = row0 + ai * HALF + m * 16; const size_t off = (size_t)row * DM + col0; float s = 0.f;
#pragma unroll
                for (int bj = 0; bj < 2; ++bj)
#pragma unroll
                    for (int n = 0; n < 2; ++n) { const f32x4 bs = *(const f32x4*)(base + off + bj * HALF + n * 16); const f32x4 v = bs + acc[ai][bj][m][n] + bv[bj][n];
                        *(f32x4*)(out + off + bj * HALF + n * 16) = v; u32x2 w; w.x = cvt_pk_bf16(v[0], v[1]); w.y = cvt_pk_bf16(v[2], v[3]);
                        *(u32x2*)(hb + off + bj * HALF + n * 16) = w; s += (v[0] * v[0] + v[1] * v[1]) + (v[2] * v[2] + v[3] * v[3]); }
                s += __shfl_xor(s, 16); s += __shfl_xor(s, 32);
                if (fq == 0) atomicAdd(ssq_out + row, s);
                asm volatile("" ::: "memory"); }
    }
};

template <class Epi, class Sched, bool ALIGN_EPI = false, bool SP2 = false>
__device__ __forceinline__ void gemm_phase(PG8_LAS unsigned char* lds, const Gemm g, const Sched& S, const Epi& E) {
    int tid_l = threadIdx.x; asm volatile("" : "+v"(tid_l));
    const int tid = tid_l, wid = __builtin_amdgcn_readfirstlane(tid >> 6), lane = tid & 63, wr = wid >> 2, wc = wid & 3, fr = lane & 15, fq = lane >> 4;
    const int K = g.K, nt = K / BK;
    unsigned voffA[2], voffB[2];
#pragma unroll
    for (int i = 0; i < 2; ++i) { int R, C; stage_rc(tid * 16 + i * 8192, R, C); const int Rb = Epi::PERM ? ((R & ~31) + perm32(R & 31)) : R;
        voffA[i] = (unsigned)(R * K + C) * 2u; voffB[i] = (unsigned)(Rb * K + C) * 2u; }
    const size_t kstep = (size_t)(BK * 2);
    const size_t hstep = (size_t)HALF * K * 2;
    const size_t tstep = 2 * hstep;
    const unsigned ldsw = (unsigned)wid * 1024u;
    const int aoff = lds_byte(wr * 64 + fr, fq * 8), boff = lds_byte(wc * 32 + fr, fq * 8);
#define PG8_SA(b, h) (((b) * 2 + (h)) * HTB)
#define PG8_SB(b, h) ((4 + (b) * 2 + (h)) * HTB)
#define PG8_STAGE(bufoff, gbase, voff) do { _Pragma("unroll") for (int _i = 0; _i < 2; ++_i) \
        __builtin_amdgcn_global_load_lds((const unsigned*)((const char*)(gbase) + (voff)[_i]), (PG8_LAS unsigned*)(lds + (bufoff) + ldsw + _i * 8192), 16, 0, 0); } while (0)
#define PG8_LDA(dst, b, h) do { _Pragma("unroll") for (int m = 0; m < 4; ++m) _Pragma("unroll") for (int k = 0; k < 2; ++k) dst[m][k] = *(const PG8_LAS bf16x8*)(lds + PG8_SA(b, h) + aoff + m * 2048 + k * 1024); } while (0)
#define PG8_LDB(dst, b, h) do { _Pragma("unroll") for (int n = 0; n < 2; ++n) _Pragma("unroll") for (int k = 0; k < 2; ++k) dst[n][k] = *(const PG8_LAS bf16x8*)(lds + PG8_SB(b, h) + boff + n * 2048 + k * 1024); } while (0)
#define PG8_MMA(ai, bj, At, Bt) do { __builtin_amdgcn_s_setprio(1); _Pragma("unroll") for (int m = 0; m < 4; ++m) _Pragma("unroll") for (int n = 0; n < 2; ++n) _Pragma("unroll") for (int k = 0; k < 2; ++k) \
        acc[ai][bj][m][n] = __builtin_amdgcn_mfma_f32_16x16x32_bf16(Bt[n][k], At[m][k], acc[ai][bj][m][n], 0, 0, 0); __builtin_amdgcn_s_setprio(0); } while (0)
#define PG8_WAIT_V(n) asm volatile("s_waitcnt vmcnt(" #n ")" ::: "memory")
#define PG8_WAIT_L(n) asm volatile("s_waitcnt lgkmcnt(" #n ")" ::: "memory")
#define PG8_BAR __builtin_amdgcn_s_barrier()
#define PG8_SCHED __builtin_amdgcn_sched_barrier(0)
    Unit cur, nxt; int ui = 0;
    if (!S.next(0, cur)) return;
    f32x4 acc[2][2][4][2];
#pragma unroll
    for (int a = 0; a < 2; ++a)
#pragma unroll
        for (int b = 0; b < 2; ++b)
#pragma unroll
            for (int m = 0; m < 4; ++m)
#pragma unroll
                for (int n = 0; n < 2; ++n) acc[a][b][m][n] = (f32x4){0.f, 0.f, 0.f, 0.f};
    bf16x8 At[4][2], B0[2][2], B1[2][2];
    const char* cA = (const char*)g.A + (size_t)cur.pm * tstep; const char* cB = (const char*)g.Bt + (size_t)cur.pn * tstep;
    S.a_ready(cur);
    if constexpr (SP2) {
        PG8_STAGE(PG8_SB(0, 0), cB, voffB); PG8_STAGE(PG8_SB(0, 1), cB + hstep, voffB); PG8_STAGE(PG8_SA(0, 0), cA, voffA); PG8_STAGE(PG8_SA(0, 1), cA + hstep, voffA);
        if (wr == 1) PG8_BAR;
        PG8_WAIT_V(2); PG8_BAR;
        PG8_STAGE(PG8_SB(1, 0), cB + kstep, voffB); PG8_STAGE(PG8_SA(1, 0), cA + kstep, voffA); PG8_STAGE(PG8_SB(1, 1), cB + hstep + kstep, voffB);
        PG8_WAIT_V(6); PG8_BAR;
    } else {
        PG8_STAGE(PG8_SB(0, 0), cB, voffB); PG8_STAGE(PG8_SA(0, 0), cA, voffA); PG8_STAGE(PG8_SB(0, 1), cB + hstep, voffB); PG8_STAGE(PG8_SA(0, 1), cA + hstep, voffA);
        if (wr == 1) PG8_BAR;
        PG8_WAIT_V(4); PG8_BAR;
        PG8_STAGE(PG8_SB(1, 0), cB + kstep, voffB); PG8_STAGE(PG8_SA(1, 0), cA + kstep, voffA); PG8_STAGE(PG8_SB(1, 1), cB + hstep + kstep, voffB);
        PG8_WAIT_V(6); PG8_BAR;
    }
    for (;;) {
        const bool has_next = S.next(ui + 1, nxt);
        const char* nA = has_next ? (const char*)g.A + (size_t)nxt.pm * tstep : cA; const char* nB = has_next ? (const char*)g.Bt + (size_t)nxt.pn * tstep : cB;
        for (int t = 0; t < nt; t += 2) {
            const bool last = (t == nt - 2);
            const char* a1 = cA + (size_t)(t + 1) * kstep;
            const char* a2 = last ? nA : cA + (size_t)(t + 2) * kstep; const char* b2 = last ? nB : cB + (size_t)(t + 2) * kstep;
            const char* a3 = a2 + kstep; const char* b3 = b2 + kstep;
            if (last && has_next) S.a_ready(nxt);
            if constexpr (SP2) {
            PG8_LDB(B0, 0, 0); PG8_LDB(B1, 0, 1); PG8_SCHED; PG8_LDA(At, 0, 0); PG8_STAGE(PG8_SA(1, 1), a1 + hstep, voffA);
            PG8_WAIT_V(8); PG8_WAIT_L(0); PG8_BAR; PG8_MMA(0, 0, At, B0); PG8_MMA(0, 1, At, B1); PG8_BAR; PG8_SCHED;
            PG8_LDA(At, 0, 1); PG8_STAGE(PG8_SB(0, 0), b2, voffB); PG8_STAGE(PG8_SB(0, 1), b2 + hstep, voffB); PG8_STAGE(PG8_SA(0, 0), a2, voffA);
            PG8_WAIT_V(8); PG8_WAIT_L(0); PG8_BAR; PG8_MMA(1, 0, At, B0); PG8_MMA(1, 1, At, B1); PG8_BAR; PG8_SCHED;
            PG8_LDB(B0, 1, 0); PG8_LDB(B1, 1, 1); PG8_SCHED; PG8_LDA(At, 1, 0); PG8_STAGE(PG8_SA(0, 1), a2 + hstep, voffA);
            PG8_WAIT_V(8); PG8_WAIT_L(0); PG8_BAR; PG8_MMA(0, 0, At, B0); PG8_MMA(0, 1, At, B1); PG8_BAR; PG8_SCHED;
            PG8_LDA(At, 1, 1); PG8_STAGE(PG8_SB(1, 0), b3, voffB); PG8_STAGE(PG8_SB(1, 1), b3 + hstep, voffB); PG8_STAGE(PG8_SA(1, 0), a3, voffA);
            PG8_WAIT_V(8); PG8_WAIT_L(0); PG8_BAR; PG8_MMA(1, 0, At, B0); PG8_MMA(1, 1, At, B1); PG8_BAR; PG8_SCHED;
            } else {
            PG8_LDB(B0, 0, 0); PG8_SCHED; PG8_LDA(At, 0, 0); PG8_STAGE(PG8_SA(1, 1), a1 + hstep, voffA);
            PG8_WAIT_L(8); PG8_BAR; PG8_WAIT_L(0); PG8_MMA(0, 0, At, B0); PG8_BAR; PG8_SCHED;
            PG8_LDB(B1, 0, 1); PG8_STAGE(PG8_SB(0, 0), b2, voffB);
            PG8_BAR; PG8_WAIT_L(0); PG8_MMA(0, 1, At, B1); PG8_BAR;
            PG8_LDA(At, 0, 1); PG8_STAGE(PG8_SA(0, 0), a2, voffA);
            PG8_BAR; PG8_WAIT_L(0); PG8_MMA(1, 0, At, B0); PG8_BAR; PG8_SCHED;
            PG8_STAGE(PG8_SB(0, 1), b2 + hstep, voffB);
            PG8_WAIT_V(6); PG8_BAR; PG8_MMA(1, 1, At, B1); PG8_BAR;
            PG8_LDB(B0, 1, 0); PG8_SCHED; PG8_LDA(At, 1, 0); PG8_STAGE(PG8_SA(0, 1), a2 + hstep, voffA);
            PG8_WAIT_L(8); PG8_BAR; PG8_WAIT_L(0); PG8_MMA(0, 0, At, B0); PG8_BAR; PG8_SCHED;
            PG8_LDB(B1, 1, 1); PG8_STAGE(PG8_SB(1, 0), b3, voffB);
            PG8_BAR; PG8_WAIT_L(0); PG8_MMA(0, 1, At, B1); PG8_BAR;
            PG8_LDA(At, 1, 1); PG8_STAGE(PG8_SA(1, 0), a3, voffA);
            PG8_BAR; PG8_WAIT_L(0); PG8_MMA(1, 0, At, B0); PG8_BAR; PG8_SCHED;
            PG8_STAGE(PG8_SB(1, 1), b3 + hstep, voffB);
            PG8_WAIT_V(6); PG8_BAR; PG8_MMA(1, 1, At, B1); PG8_BAR;
            }
        }
        if constexpr (ALIGN_EPI) { if (wr == 0) PG8_BAR; }
        if constexpr (!Epi::AFTER_DRAIN) { E(acc, cur, wr, wc, fr, fq); S.done(cur); }
        if (!has_next) break;
#pragma unroll
        for (int a = 0; a < 2; ++a)
#pragma unroll
            for (int b = 0; b < 2; ++b)
#pragma unroll
                for (int m = 0; m < 4; ++m)
#pragma unroll
                    for (int n = 0; n < 2; ++n) acc[a][b][m][n] = (f32x4){0.f, 0.f, 0.f, 0.f};
        cur = nxt; cA = nA; cB = nB; ++ui;
        if constexpr (ALIGN_EPI) { if (wr == 1) PG8_BAR; }
    }
    PG8_WAIT_V(0);
    if constexpr (!ALIGN_EPI) { if (wr == 0) PG8_BAR; }
    PG8_BAR;
    if constexpr (Epi::AFTER_DRAIN) { E.fused(acc, cur, wr, wc, fr, fq, lds, wid, lane); S.done(cur); }
#undef PG8_SA
#undef PG8_SB
#undef PG8_STAGE
#undef PG8_LDA
#undef PG8_LDB
#undef PG8_MMA
#undef PG8_WAIT_V
#undef PG8_WAIT_L
#undef PG8_BAR
#undef PG8_SCHED
}
}

#define LAS __attribute__((address_space(3)))
typedef unsigned short bf16;
typedef unsigned v4u __attribute__((ext_vector_type(4)));
typedef unsigned v2u __attribute__((ext_vector_type(2)));
typedef float f32x4 __attribute__((ext_vector_type(4)));
typedef float f32x16 __attribute__((ext_vector_type(16)));
typedef short bf16x8 __attribute__((ext_vector_type(8)));
using pg8::cvt_pk_bf16;

constexpr int NWAVES = 8;
constexpr int BATCH = 8, SEQ = 4096, D = 1024, FF = 4096, M = BATCH * SEQ;
constexpr size_t MiB = 1u << 20;
constexpr size_t WS_SSQ = 0;
constexpr size_t WS_BAR = 1280 * 1024;
constexpr size_t WS_TAB = 1536 * 1024;
constexpr size_t WS_WA_QKV = 2 * MiB, WS_WA_O = 8 * MiB, WA_STRIDE = 8 * MiB;
constexpr size_t WS_WB_Q0 = 18 * MiB;
constexpr size_t WS_WB_Q1 = 21 * MiB;
constexpr size_t WS_WB_O = 23 * MiB;
constexpr size_t WS_WUP = 27 * MiB, WS_WDN = 35 * MiB, WM_STRIDE = 16 * MiB;
constexpr size_t WS_HB = 92 * MiB;
constexpr size_t WS_KSH = 156 * MiB, WS_VTSH = 164 * MiB;
constexpr size_t WS_BIG = 172 * MiB;
constexpr size_t WS_END = 428 * MiB;
constexpr int LDS_BYTES = 147456;

__device__ __forceinline__ float wave_sum(float v) {
#pragma unroll
    for (int o = 1; o < 64; o <<= 1) v += __shfl_xor(v, o);
    return v;
}
typedef float f32x2_t __attribute__((ext_vector_type(2))); typedef __bf16 bf16x2_t __attribute__((ext_vector_type(2)));
__device__ __forceinline__ unsigned pk2(float lo, float hi) { f32x2_t v = {lo, hi}; bf16x2_t b = __builtin_convertvector(v, bf16x2_t); return __builtin_bit_cast(unsigned, b); }

__device__ __forceinline__ void transpose_item(const float* W, const float* gain, int K, int N, bf16* WT, int row_off, LAS float* scr, int item, int lane) {
    const int nblk = N / 32, kb = item / nblk, nb = item % nblk, k0 = 64 * kb, n0 = 32 * nb;
    const float* wp = W + (size_t)(k0 + (lane >> 5)) * N + n0 + (lane & 31);
    float v[32];
#pragma unroll
    for (int i = 0; i < 32; ++i) v[i] = wp[(size_t)(2 * i) * N];
    const int c = lane & 7;
    f32x4 g0 = {1.f, 1.f, 1.f, 1.f}, g1 = {1.f, 1.f, 1.f, 1.f};
    if (gain) { g0 = *(const f32x4*)(gain + k0 + 8 * c); g1 = *(const f32x4*)(gain + k0 + 8 * c + 4); }
#pragma unroll
    for (int i = 0; i < 32; ++i) scr[(2 * i + (lane >> 5)) * 33 + (lane & 31)] = v[i];
    asm volatile("s_waitcnt lgkmcnt(0)" ::: "memory");
#pragma unroll
    for (int j = 0; j < 4; ++j) { const int n = (lane >> 3) + 8 * j; const LAS float* s = scr + (8 * c) * 33 + n;
        v4u o; o.x = pk2(s[0 * 33] * g0.x, s[1 * 33] * g0.y); o.y = pk2(s[2 * 33] * g0.z, s[3 * 33] * g0.w); o.z = pk2(s[4 * 33] * g1.x, s[5 * 33] * g1.y); o.w = pk2(s[6 * 33] * g1.z, s[7 * 33] * g1.w);
        *(v4u*)(WT + (size_t)(row_off + n0 + n) * K + k0 + 8 * c) = o; }
    asm volatile("s_waitcnt lgkmcnt(0)" ::: "memory");
}

__device__ __forceinline__ int pi32(int m) { return (m & ~12) | ((m & 4) << 1) | ((m & 8) >> 1); }
#define MFMA32(a, b, c) __builtin_amdgcn_mfma_f32_32x32x16_bf16((a), (b), (c), 0, 0, 0)
constexpr float LOG2E = 1.4426950408889634f, LN2 = 0.6931471805599453f;

__device__ __forceinline__ void sb_attn_phase(const bf16* Q, const bf16* K, const bf16* VT, bf16* O, int gw, int ngw, int lane_in) {
    int lane = lane_in; asm volatile("" : "+v"(lane));
    const int ql = lane & 31, hi = lane >> 5, kperm = pi32(ql);
    for (int unit = gw; unit < BATCH * 16 * (SEQ / 32); unit += ngw) {
        const int qt = unit & 127, bh = unit >> 7, h = bh & 15, b = bh >> 4, q0 = qt * 32, t = q0 + ql;
        const size_t tok0 = (size_t)b * SEQ;
        const bf16* qp = Q + (tok0 + q0 + ql) * D + h * 64 + 8 * hi;
        bf16x8 qf[4];
#pragma unroll
        for (int kk = 0; kk < 4; ++kk) qf[kk] = *(const bf16x8*)(qp + 16 * kk);
        f32x16 o0, o1;
#pragma unroll
        for (int r = 0; r < 16; ++r) { o0[r] = 0.f; o1[r] = 0.f; }
        float carry = 0.f;
        const bf16* kbase = K + tok0 * D + h * 64 + 8 * hi;
        const bf16* vbase = VT + ((size_t)(b * D + h * 64 + ql)) * SEQ + 8 * hi;
        for (int jb = q0 >> 6; jb >= 0; --jb) {
            const int k0 = jb * 64;
            bf16x8 kf[2][4], vf[2][4];
#pragma unroll
            for (int hf = 0; hf < 2; ++hf)
#pragma unroll
                for (int kk = 0; kk < 4; ++kk) kf[hf][kk] = *(const bf16x8*)(kbase + (size_t)(k0 + 32 * hf + kperm) * D + 16 * kk);
#pragma unroll
            for (int dh = 0; dh < 2; ++dh)
#pragma unroll
                for (int c = 0; c < 4; ++c) vf[dh][c] = *(const bf16x8*)(vbase + (size_t)(32 * dh) * SEQ + k0 + 16 * c);
            f32x16 p0, p1;
#pragma unroll
            for (int r = 0; r < 16; ++r) { p0[r] = 0.f; p1[r] = 0.f; }
#pragma unroll
            for (int kk = 0; kk < 4; ++kk) { p0 = MFMA32(kf[0][kk], qf[kk], p0); p1 = MFMA32(kf[1][kk], qf[kk], p1); }
            float L[4][8], ls[4][8], cs[4], pcs[4];
#pragma unroll
            for (int c = 0; c < 4; ++c) { float acc = 0.f;
#pragma unroll
                for (int i = 0; i < 8; ++i) {
                    const float z = ((c < 2) ? p0[8 * (c & 1) + i] : p1[8 * (c & 1) + i]) * 0.125f;
                    const bool valid = (k0 + 16 * c + 8 * hi + i) < t;
                    const float e = __builtin_amdgcn_exp2f(-fabsf(z) * LOG2E);
                    const float sp = __builtin_amdgcn_logf(1.0f + e) * LN2;
                    L[c][i] = valid ? -(fmaxf(z, 0.f) + sp) : 0.f;
                    ls[c][i] = valid ? (fminf(z, 0.f) - sp) : -1e30f;
                    acc += L[c][i]; }
                cs[c] = acc; }
#pragma unroll
            for (int c = 0; c < 4; ++c) pcs[c] = __shfl_xor(cs[c], 32);
            float run = carry;
            bf16x8 wf[4];
#pragma unroll
            for (int c = 3; c >= 0; --c) {
                float r_ = run + (hi == 0 ? pcs[c] : 0.f);
                float w[8];
#pragma unroll
                for (int i = 7; i >= 0; --i) { w[i] = __builtin_amdgcn_exp2f((ls[c][i] + r_) * LOG2E); r_ += L[c][i]; }
                v4u pk; pk.x = pk2(w[0], w[1]); pk.y = pk2(w[2], w[3]); pk.z = pk2(w[4], w[5]); pk.w = pk2(w[6], w[7]);
                wf[c] = __builtin_bit_cast(bf16x8, pk);
                run += cs[c] + pcs[c]; }
            carry = run;
#pragma unroll
            for (int c = 0; c < 4; ++c) { o0 = MFMA32(vf[0][c], wf[c], o0); o1 = MFMA32(vf[1][c], wf[c], o1); }
            if (__all(carry < -104.0f)) break;
        }
        bf16* op = O + (tok0 + q0 + ql) * D + h * 64 + 4 * hi;
#pragma unroll
        for (int g = 0; g < 4; ++g) {
            v2u a; a.x = pk2(o0[4 * g], o0[4 * g + 1]); a.y = pk2(o0[4 * g + 2], o0[4 * g + 3]); *(v2u*)(op + 8 * g) = a;
            v2u c; c.x = pk2(o1[4 * g], o1[4 * g + 1]); c.y = pk2(o1[4 * g + 2], o1[4 * g + 3]); *(v2u*)(op + 32 + 8 * g) = c; }
    }
}

__device__ __forceinline__ void swa_attn_phase(const bf16* Q, const bf16* Ksh, const bf16* VTsh, bf16* O, const float* sinks, const LAS float* tab, int gw, int ngw, int lane_in) {
    int lane = lane_in; asm volatile("" : "+v"(lane));
    const int ql = lane & 31, hi = lane >> 5, kperm = pi32(ql);
    for (int unit = gw; unit < BATCH * 16 * (SEQ / 32); unit += ngw) {
        const int qt = unit & 127, bh = unit >> 7, qh = bh & 15, b = bh >> 4, kvh = qh >> 3, q0 = qt * 32, t = q0 + ql;
        const size_t tok0 = (size_t)b * SEQ;
        const bf16* qp = Q + (tok0 + q0 + ql) * D + qh * 64 + 8 * hi;
        bf16x8 qf[4];
#pragma unroll
        for (int kk = 0; kk < 4; ++kk) qf[kk] = *(const bf16x8*)(qp + 16 * kk);
        const float sink = sinks[qh];
        const LAS float* tb = tab + qh * 128;
        bf16x8 kf[5][4], vf[5][2][2];
        const bf16* vbase = VTsh + ((size_t)(b * 128 + kvh * 64 + ql)) * SEQ + 8 * hi;
#pragma unroll
        for (int j = 0; j < 5; ++j) {
            const int k0 = q0 - 128 + 32 * j;
            if (k0 >= 0) {
                const bf16* kp = Ksh + (tok0 + k0 + kperm) * 128 + kvh * 64 + 8 * hi;
#pragma unroll
                for (int kk = 0; kk < 4; ++kk) kf[j][kk] = *(const bf16x8*)(kp + 16 * kk);
            } else {
#pragma unroll
                for (int kk = 0; kk < 4; ++kk) kf[j][kk] = (bf16x8){0, 0, 0, 0, 0, 0, 0, 0};
            }
        }
        f32x16 p[5];
        float mx = sink;
#pragma unroll
        for (int j = 0; j < 5; ++j) {
#pragma unroll
            for (int r = 0; r < 16; ++r) p[j][r] = 0.f;
#pragma unroll
            for (int kk = 0; kk < 4; ++kk) p[j] = MFMA32(kf[j][kk], qf[kk], p[j]);
        }
        __builtin_amdgcn_sched_barrier(0);
#pragma unroll
        for (int j = 0; j < 5; ++j) {
            const int k0 = q0 - 128 + 32 * j;
            if (k0 >= 0) {
#pragma unroll
                for (int a = 0; a < 2; ++a) { vf[j][a][0] = *(const bf16x8*)(vbase + k0 + 16 * a); vf[j][a][1] = *(const bf16x8*)(vbase + (size_t)32 * SEQ + k0 + 16 * a); }
            } else {
#pragma unroll
                for (int a = 0; a < 2; ++a) { vf[j][a][0] = (bf16x8){0, 0, 0, 0, 0, 0, 0, 0}; vf[j][a][1] = (bf16x8){0, 0, 0, 0, 0, 0, 0, 0}; }
            }
        }
#pragma unroll
        for (int j = 0; j < 5; ++j) {
            const int k0 = q0 - 128 + 32 * j;
#pragma unroll
            for (int r = 0; r < 16; ++r) {
                const int dist = t - (k0 + 16 * (r >> 3) + 8 * hi + (r & 7));
                const bool valid = (k0 >= 0) && dist >= 0 && dist < 128;
                const float s = valid ? (p[j][r] * 0.125f + tb[dist & 127]) : -1e30f;
                p[j][r] = s; mx = fmaxf(mx, s); }
        }
        mx = fmaxf(mx, __shfl_xor(mx, 32));
        float sum = 0.f;
        bf16x8 pf[5][2];
#pragma unroll
        for (int j = 0; j < 5; ++j) {
            float e[16];
#pragma unroll
            for (int r = 0; r < 16; ++r) { e[r] = __builtin_amdgcn_exp2f((p[j][r] - mx) * LOG2E); sum += e[r]; }
#pragma unroll
            for (int a = 0; a < 2; ++a) { v4u pk; pk.x = pk2(e[8 * a], e[8 * a + 1]); pk.y = pk2(e[8 * a + 2], e[8 * a + 3]); pk.z = pk2(e[8 * a + 4], e[8 * a + 5]); pk.w = pk2(e[8 * a + 6], e[8 * a + 7]);
                pf[j][a] = __builtin_bit_cast(bf16x8, pk); }
        }
        sum += __shfl_xor(sum, 32);
        sum += __builtin_amdgcn_exp2f((sink - mx) * LOG2E);
        const float inv = 1.0f / sum;
        f32x16 o0, o1;
#pragma unroll
        for (int r = 0; r < 16; ++r) { o0[r] = 0.f; o1[r] = 0.f; }
#pragma unroll
        for (int j = 0; j < 5; ++j)
#pragma unroll
            for (int a = 0; a < 2; ++a) { o0 = MFMA32(vf[j][a][0], pf[j][a], o0); o1 = MFMA32(vf[j][a][1], pf[j][a], o1); }
        bf16* op = O + (tok0 + q0 + ql) * D + qh * 64 + 4 * hi;
#pragma unroll
        for (int g = 0; g < 4; ++g) {
            v2u a; a.x = pk2(o0[4 * g] * inv, o0[4 * g + 1] * inv); a.y = pk2(o0[4 * g + 2] * inv, o0[4 * g + 3] * inv); *(v2u*)(op + 8 * g) = a;
            v2u c; c.x = pk2(o1[4 * g] * inv, o1[4 * g + 1] * inv); c.y = pk2(o1[4 * g + 2] * inv, o1[4 * g + 3] * inv); *(v2u*)(op + 32 + 8 * g) = c; }
    }
}


__device__ __forceinline__ float bf2f(bf16 v) { return __uint_as_float((unsigned)v << 16); }
__device__ __forceinline__ void sb_attn_naive(const bf16* Q, const bf16* K, const bf16* VT, bf16* O, int gtid_in, int gthreads) {
    int gtid = gtid_in; asm volatile("" : "+v"(gtid));
    for (int idx = gtid; idx < BATCH * 16 * SEQ; idx += gthreads) {
        const int t = idx & 4095, bh = idx >> 12, h = bh & 15, b = bh >> 4;
        const size_t tok0 = (size_t)b * SEQ;
        float o[64]; const bf16* q = Q + (tok0 + t) * D + h * 64;
#pragma unroll
        for (int d = 0; d < 64; ++d) o[d] = 0.f;
        float carry = 0.f;
        for (int s = t - 1; s >= 0; --s) {
            float z = 0.f;
#pragma unroll
            for (int d = 0; d < 64; ++d) z += bf2f(q[d]) * bf2f(K[(tok0 + s) * D + h * 64 + d]);
            z *= 0.125f;
            const float sp = __builtin_amdgcn_logf(1.0f + __builtin_amdgcn_exp2f(-fabsf(z) * 1.4426950408889634f)) * 0.6931471805599453f;
            const float w = __builtin_amdgcn_exp2f((fminf(z, 0.f) - sp + carry) * 1.4426950408889634f);
            carry += -(fmaxf(z, 0.f) + sp);
#pragma unroll
            for (int d = 0; d < 64; ++d) o[d] += w * bf2f(VT[((size_t)(b * D + h * 64 + d)) * SEQ + s]);
            if (carry < -104.f) break;
        }
#pragma unroll
        for (int d = 0; d < 64; ++d) O[(tok0 + t) * D + h * 64 + d] = pg8::bf1(o[d]);
    }
}
__device__ __forceinline__ void swa_attn_naive(const bf16* Q, const bf16* Ksh, const bf16* VTsh, bf16* O, const float* sinks, const float* tabg, int gtid_in, int gthreads) {
    int gtid = gtid_in; asm volatile("" : "+v"(gtid));
    for (int idx = gtid; idx < BATCH * 16 * SEQ; idx += gthreads) {
        const int t = idx & 4095, bh = idx >> 12, qh = bh & 15, b = bh >> 4, kvh = qh >> 3;
        const size_t tok0 = (size_t)b * SEQ;
        float o[64]; const bf16* q = Q + (tok0 + t) * D + qh * 64;
#pragma unroll
        for (int d = 0; d < 64; ++d) o[d] = 0.f;
        const float sink = sinks[qh];
        float mx = sink, sum = 0.f;
        const int s_lo = t - 127 > 0 ? t - 127 : 0;
        for (int s = s_lo; s <= t; ++s) {
            float z = 0.f;
#pragma unroll
            for (int d = 0; d < 64; ++d) z += bf2f(q[d]) * bf2f(Ksh[(tok0 + s) * 128 + kvh * 64 + d]);
            z = z * 0.125f + tabg[qh * 128 + (t - s)];
            const float nm = fmaxf(mx, z), sc = __builtin_amdgcn_exp2f((mx - nm) * 1.4426950408889634f), e = __builtin_amdgcn_exp2f((z - nm) * 1.4426950408889634f);
            sum = sum * sc + e; mx = nm;
#pragma unroll
            for (int d = 0; d < 64; ++d) o[d] = o[d] * sc + e * bf2f(VTsh[((size_t)(b * 128 + kvh * 64 + d)) * SEQ + s]);
        }
        sum += __builtin_amdgcn_exp2f((sink - mx) * 1.4426950408889634f);
        const float inv = 1.0f / sum;
#pragma unroll
        for (int d = 0; d < 64; ++d) O[(tok0 + t) * D + qh * 64 + d] = pg8::bf1(o[d] * inv);
    }
}
#define XB_TMO      128
#define XB_XCNT(j)  (256  + 64 * (j))
#define XB_XSUB(j)  (1280 + 64 * (j))
#define XB_XGEN(j)  (2304 + 64 * (j))
#define XB_TOP      3328
#define XB_TOPGEN   3392
#define XCD_BAR_WORDS 3456
#define XB_SPIN_CAP (1u << 18)

__device__ __forceinline__ unsigned xb_ld(unsigned* p)              { return __hip_atomic_load(p, __ATOMIC_RELAXED, __HIP_MEMORY_SCOPE_AGENT); }
__device__ __forceinline__ unsigned xb_add(unsigned* p, unsigned v) { return __hip_atomic_fetch_add(p, v, __ATOMIC_RELAXED, __HIP_MEMORY_SCOPE_AGENT); }
__device__ __forceinline__ unsigned xb_xcc_id() { return (unsigned)__builtin_amdgcn_s_getreg((3 << 11) | 20) & 0xFu; }
#define XB_SPIN(cond, bar) do { unsigned _sp = 0; while (cond) { __builtin_amdgcn_s_sleep(1); \
    if ((++_sp & 255u) == 0u) { if (xb_ld(&(bar)[XB_TMO])) break; if (_sp > XB_SPIN_CAP) { atomicAdd(&(bar)[XB_TMO], 1u); break; } } } } while (0)

struct XcdBarrier {
    unsigned* bar; unsigned x;
    volatile LAS unsigned* st;
};

__device__ __forceinline__ XcdBarrier xcd_barrier_post(unsigned* bar, volatile LAS unsigned* st) {
    XcdBarrier b; b.bar = bar; b.x = xb_xcc_id(); b.st = st;
    if (threadIdx.x == 0) (void)xb_add(&bar[XB_XCNT(b.x)], 1u);
    return b;
}
__device__ __forceinline__ void xcd_barrier_complete(unsigned* bar, unsigned x, unsigned& nloc, unsigned& nx) {
    const unsigned G = gridDim.x * gridDim.y * gridDim.z;
    unsigned sum, cnt, mine, sp = 0u;
    for (;;) {
        sum = 0u; cnt = 0u; mine = 0u;
#pragma unroll
        for (unsigned j = 0; j < 16; ++j) { const unsigned c = xb_ld(&bar[XB_XCNT(j)]); sum += c; cnt += (c > 0u) ? 1u : 0u; mine = (j == x) ? c : mine; }
        if (sum == G) break;
        __builtin_amdgcn_s_sleep(1);
        if ((++sp & 255u) == 0u) { if (xb_ld(&bar[XB_TMO])) break; if (sp > XB_SPIN_CAP) { atomicAdd(&bar[XB_TMO], 1u); break; } }
    }
    nloc = mine > 0u ? mine : 1u; nx = cnt > 0u ? cnt : 1u;
}

__device__ __forceinline__ void xcd_barrier(const XcdBarrier& b) {
    asm volatile("s_waitcnt vmcnt(0)" ::: "memory");
    __syncthreads();
    if (threadIdx.x == 0) {
        unsigned* bar = b.bar;
        __builtin_amdgcn_s_waitcnt(0);
        unsigned nloc = b.st[0], nx = b.st[1];
        if (nloc == 0u) { xcd_barrier_complete(bar, b.x, nloc, nx); b.st[0] = nloc; b.st[1] = nx; }
        const unsigned old = xb_add(&bar[XB_XSUB(b.x)], 1u);
        const unsigned gen = old / nloc;
        if (old + 1u == (gen + 1u) * nloc) {
            __builtin_amdgcn_fence(__ATOMIC_RELEASE, "agent");
            asm volatile("s_waitcnt vmcnt(0)" ::: "memory");
            const unsigned og = xb_add(&bar[XB_TOP], 1u);
            const unsigned tg = og / nx;
            if (og + 1u == (tg + 1u) * nx) xb_add(&bar[XB_TOPGEN], 1u);
            else XB_SPIN(xb_ld(&bar[XB_TOPGEN]) == tg, bar);
            __builtin_amdgcn_fence(__ATOMIC_ACQUIRE, "agent");
            xb_add(&bar[XB_XGEN(b.x)], 1u);
            asm volatile("s_waitcnt vmcnt(0)" ::: "memory");
        } else {
            XB_SPIN(xb_ld(&bar[XB_XGEN(b.x)]) == gen, bar);
            __builtin_amdgcn_fence(__ATOMIC_ACQUIRE, "agent");
            asm volatile("s_waitcnt vmcnt(0)" ::: "memory");
        }
    }
    __syncthreads();
}

#ifndef REP_PRO
#define REP_PRO 1
#endif
#ifndef REP_QKV
#define REP_QKV 1
#endif
#ifndef REP_SB
#define REP_SB 1
#endif
#ifndef REP_SWA
#define REP_SWA 1
#endif
#ifndef REP_UP
#define REP_UP 1
#endif
#ifndef EXTRA_SYNC
#define EXTRA_SYNC 0
#endif
#ifndef ONLY
#define ONLY -1
#endif
#define PH(n) (ONLY < 0 || ONLY == (n))
struct Args { const float* in[18]; float* out; unsigned char* ws; };

__global__ void __launch_bounds__(NWAVES * 64, 2) yoco_fwd(Args args) {
    extern __shared__ __attribute__((aligned(16))) unsigned char lds_raw[];
    cg::grid_group grid = cg::this_grid();
    LAS unsigned char* lds = (LAS unsigned char*)lds_raw;
    const int tid = threadIdx.x, lane = tid & 63, wave = __builtin_amdgcn_readfirstlane(tid >> 6);
    const int G = gridDim.x, bx = blockIdx.x;
    const int vcu = (G % 8 == 0) ? (bx % 8) * (G / 8) + bx / 8 : bx;
    const int gw = vcu * NWAVES + wave, NGW = G * NWAVES;
    volatile LAS unsigned long long* slots = (volatile LAS unsigned long long*)(lds + 131072 + 2048);
    if (tid == 0) {
#pragma unroll
        for (int i = 0; i < 18; ++i) slots[i] = (unsigned long long)args.in[i];
        slots[18] = (unsigned long long)args.out; slots[19] = (unsigned long long)args.ws;
    }
    __syncthreads();
#define GP(i) ((const float*)(((unsigned long long)(unsigned)__builtin_amdgcn_readfirstlane((unsigned)(slots[i] >> 32)) << 32) | (unsigned long long)(unsigned)__builtin_amdgcn_readfirstlane((unsigned)slots[i])))
#define P_x GP(0)
#define P_a_norm GP(1)
#define P_a_wqkv GP(2)
#define P_a_wo GP(3)
#define P_kv_norm GP(4)
#define P_w_kv GP(5)
#define P_b_kv GP(6)
#define P_b_norm GP(7)
#define P_b_wq GP(8)
#define P_b_bq GP(9)
#define P_b_sinks GP(10)
#define P_b_wo GP(11)
#define P_b_bo GP(12)
#define P_rel_bias GP(13)
#define P_mlp_norm GP(14)
#define P_mlp_up GP(15)
#define P_mlp_down GP(16)
#define P_final_norm GP(17)
#define P_out ((float*)GP(18))
#define P_ws ((unsigned char*)GP(19))
#define P_ssq ((float*)(P_ws + WS_SSQ))
#define P_tabg ((float*)(P_ws + WS_TAB))
#define P_HB ((bf16*)(P_ws + WS_HB))
#define P_KSH ((bf16*)(P_ws + WS_KSH))
#define P_VTSH ((bf16*)(P_ws + WS_VTSH))
#define P_U ((bf16*)(P_ws + WS_BIG))
#define P_Qb ((bf16*)(P_ws + WS_BIG))
#define P_Kb ((bf16*)(P_ws + WS_BIG + 64 * MiB))
#define P_VTb ((bf16*)(P_ws + WS_BIG + 128 * MiB))
#define P_Ob ((bf16*)(P_ws + WS_BIG + 192 * MiB))

    for (int rep = 0; rep < REP_PRO; ++rep) if (PH(0)) {
        LAS float* scr = (LAS float*)(lds + wave * 16384);
        constexpr int I_QKV = (D / 64) * (3 * D / 32), I_DD = (D / 64) * (D / 32), I_KV = (D / 64) * (256 / 32), I_UP = (D / 64) * (FF / 32), I_DN = (FF / 64) * (D / 32);
        constexpr int NITEMS = 2 * (I_QKV + I_DD) + (I_DD + I_KV) + I_DD + 2 * I_DD + 4 * (I_UP + I_DN);
        for (int it = gw; it < NITEMS; it += NGW) {
            int r = it; bool done = false;
#pragma unroll
            for (int l = 0; l < 2; ++l) {
                if (!done && r < I_QKV) { transpose_item(P_a_wqkv + (size_t)l * D * 3 * D, P_a_norm + l * D, D, 3 * D, (bf16*)(P_ws + WS_WA_QKV + l * WA_STRIDE), 0, scr, r, lane); done = true; } if (!done) r -= I_QKV;
                if (!done && r < I_DD) { transpose_item(P_a_wo + (size_t)l * D * D, nullptr, D, D, (bf16*)(P_ws + WS_WA_O + l * WA_STRIDE), 0, scr, r, lane); done = true; } if (!done) r -= I_DD;
            }
            if (!done && r < I_DD) { transpose_item(P_b_wq, P_b_norm, D, D, (bf16*)(P_ws + WS_WB_Q0), 0, scr, r, lane); done = true; } if (!done) r -= I_DD;
            if (!done && r < I_KV) { transpose_item(P_w_kv, P_kv_norm, D, 256, (bf16*)(P_ws + WS_WB_Q0), 1024, scr, r, lane); done = true; } if (!done) r -= I_KV;
            if (!done && r < I_DD) { transpose_item(P_b_wq + (size_t)D * D, P_b_norm + D, D, D, (bf16*)(P_ws + WS_WB_Q1), 0, scr, r, lane); done = true; } if (!done) r -= I_DD;
#pragma unroll
            for (int j = 0; j < 2; ++j) { if (!done && r < I_DD) { transpose_item(P_b_wo + (size_t)j * D * D, nullptr, D, D, (bf16*)(P_ws + WS_WB_O + j * 2 * MiB), 0, scr, r, lane); done = true; } if (!done) r -= I_DD; }
#pragma unroll
            for (int l = 0; l < 4; ++l) {
                if (!done && r < I_UP) { transpose_item(P_mlp_up + (size_t)l * D * FF, P_mlp_norm + l * D, D, FF, (bf16*)(P_ws + WS_WUP + l * WM_STRIDE), 0, scr, r, lane); done = true; } if (!done) r -= I_UP;
                if (!done && r < I_DN) { transpose_item(P_mlp_down + (size_t)l * FF * D, nullptr, FF, D, (bf16*)(P_ws + WS_WDN + l * WM_STRIDE), 0, scr, r, lane); done = true; } if (!done) r -= I_DN;
            }
        }
        { const float* xp = P_x; bf16* hbp = P_HB; float* sq = P_ssq;
          for (int m = gw; m < M; m += 2 * NGW) {
            const int m2 = m + NGW;
            const f32x4* xr = (const f32x4*)(xp + (size_t)m * D) + lane; const f32x4* xr2 = (const f32x4*)(xp + (size_t)m2 * D) + lane;
            f32x4 va[4], vb[4];
#pragma unroll
            for (int j = 0; j < 4; ++j) { va[j] = xr[64 * j]; vb[j] = xr2[64 * j]; }
            unsigned long long* o8 = (unsigned long long*)(hbp + (size_t)m * D) + lane; unsigned long long* o82 = (unsigned long long*)(hbp + (size_t)m2 * D) + lane;
            float s = 0.f, s2 = 0.f;
#pragma unroll
            for (int j = 0; j < 4; ++j) { const f32x4 v = va[j], w = vb[j];
                s += (v.x * v.x + v.y * v.y) + (v.z * v.z + v.w * v.w); s2 += (w.x * w.x + w.y * w.y) + (w.z * w.z + w.w * w.w);
                o8[64 * j] = (unsigned long long)pk2(v.x, v.y) | ((unsigned long long)pk2(v.z, v.w) << 32);
                o82[64 * j] = (unsigned long long)pk2(w.x, w.y) | ((unsigned long long)pk2(w.z, w.w) << 32); }
            s = wave_sum(s); s2 = wave_sum(s2);
            if (lane == 0) { sq[m] = s; sq[m2] = s2; }
          } }
        { float* sq = P_ssq; for (int i = bx * (NWAVES * 64) + tid; i < 8 * M; i += G * NWAVES * 64) sq[M + i] = 0.f; }
        if (bx == 0) for (int i = tid; i < XCD_BAR_WORDS; i += NWAVES * 64) ((unsigned*)(P_ws + WS_BAR))[i] = 0u;
        for (int i = bx * (NWAVES * 64) + tid; i < 16 * 128; i += G * NWAVES * 64) {
            const int h = i >> 7, n = i & 127;
            int bucket = n;
            if (n >= 16) { const int lg = 16 + (int)(logf((float)n / 16.0f) / 2.0794415416798357f * 16.0f); bucket = lg < 31 ? lg : 31; }
            P_tabg[i] = P_rel_bias[bucket * 16 + h];
        }
    }
    grid.sync();
    volatile LAS unsigned* bst = (volatile LAS unsigned*)(lds + 131072 + 1024);
    if (tid < 2) bst[tid] = 0u;
    __syncthreads();
    XcdBarrier xbar = xcd_barrier_post((unsigned*)(P_ws + WS_BAR), bst);
#define GRID_BAR() xcd_barrier(xbar)

    for (int layer = 0; layer < 4; ++layer) {
        const float* ssq_in = P_ssq + (size_t)(2 * layer) * M;
        float* ssq_mid = P_ssq + (size_t)(2 * layer + 1) * M;
        float* ssq_out = P_ssq + (size_t)(2 * layer + 2) * M;
        const float* resid_in = layer == 0 ? P_x : P_out;
        if (layer < 2) {
            for (int rep = 0; rep < REP_QKV; ++rep) if (PH(1)) { pg8::Gemm g{P_HB, (const bf16*)(P_ws + WS_WA_QKV + layer * WA_STRIDE), M, 3 * D, D}; pg8::StaticOrder S; S.init(M, 3 * D, G, bx);
              pg8::EpiQKV E{P_Qb, P_Kb, P_VTb, ssq_in};
              pg8::gemm_phase<pg8::EpiQKV, pg8::StaticOrder, true, true>(lds, g, S, E); }
            GRID_BAR();
#ifdef NAIVE_SB
            if (PH(2)) sb_attn_naive(P_Qb, P_Kb, P_VTb, P_Ob, bx * 512 + tid, G * 512);
#else
            for (int rep = 0; rep < REP_SB; ++rep) if (PH(2)) sb_attn_phase(P_Qb, P_Kb, P_VTb, P_Ob, gw, NGW, lane);
#endif
            GRID_BAR();
            if (PH(3)) { pg8::Gemm g{P_Ob, (const bf16*)(P_ws + WS_WA_O + layer * WA_STRIDE), M, D, D}; pg8::StaticOrder S; S.init(M, D, G, bx);
              pg8::EpiResid E{resid_in, P_out, P_HB, nullptr, ssq_mid};
              pg8::gemm_phase<pg8::EpiResid, pg8::StaticOrder, true, true>(lds, g, S, E); }
            GRID_BAR();
        } else {
            const int j = layer - 2;
            if (PH(4)) { if (j == 0) { pg8::Gemm g{P_HB, (const bf16*)(P_ws + WS_WB_Q0), M, 1280, D}; pg8::StaticOrder S; S.init(M, 1280, G, bx);
              pg8::EpiQB<true> E{P_Qb, P_KSH, P_VTSH, P_b_bq, P_b_kv, ssq_in};
              pg8::gemm_phase<pg8::EpiQB<true>, pg8::StaticOrder, true, true>(lds, g, S, E); }
            else { pg8::Gemm g{P_HB, (const bf16*)(P_ws + WS_WB_Q1), M, D, D}; pg8::StaticOrder S; S.init(M, D, G, bx);
              pg8::EpiQB<false> E{P_Qb, P_KSH, P_VTSH, P_b_bq + D, P_b_kv, ssq_in};
              pg8::gemm_phase<pg8::EpiQB<false>, pg8::StaticOrder, true, true>(lds, g, S, E); } }
            { int t2 = tid; asm volatile("" : "+v"(t2)); LAS float* tab = (LAS float*)lds; const float* tg = P_tabg; for (int i = t2; i < 16 * 128; i += NWAVES * 64) tab[i] = tg[i]; }
            GRID_BAR();
#ifdef NAIVE_SWA
            if (PH(5)) swa_attn_naive(P_Qb, P_KSH, P_VTSH, P_Ob, P_b_sinks + j * 16, P_tabg, bx * 512 + tid, G * 512);
#else
            for (int rep = 0; rep < REP_SWA; ++rep) if (PH(5)) swa_attn_phase(P_Qb, P_KSH, P_VTSH, P_Ob, P_b_sinks + j * 16, (const LAS float*)lds, gw, NGW, lane);
#endif
            GRID_BAR();
            if (PH(3)) { pg8::Gemm g{P_Ob, (const bf16*)(P_ws + WS_WB_O + j * 2 * MiB), M, D, D}; pg8::StaticOrder S; S.init(M, D, G, bx);
              pg8::EpiResid E{resid_in, P_out, P_HB, P_b_bo + j * D, ssq_mid};
              pg8::gemm_phase<pg8::EpiResid, pg8::StaticOrder, true, true>(lds, g, S, E); }
            GRID_BAR();
        }
        for (int rep = 0; rep < REP_UP; ++rep) if (PH(6)) { pg8::Gemm g{P_HB, (const bf16*)(P_ws + WS_WUP + layer * WM_STRIDE), M, FF, D}; pg8::StaticOrder S; S.init(M, FF, G, bx);
          pg8::EpiUp E{P_U, ssq_mid};
          pg8::gemm_phase<pg8::EpiUp, pg8::StaticOrder, true, true>(lds, g, S, E); }
        for (int rep = 0; rep < EXTRA_SYNC; ++rep) GRID_BAR();
        GRID_BAR();
        if (PH(7)) { pg8::Gemm g{P_U, (const bf16*)(P_ws + WS_WDN + layer * WM_STRIDE), M, D, FF}; pg8::StaticOrder S; S.init(M, D, G, bx);
          pg8::EpiResid E{P_out, P_out, P_HB, nullptr, ssq_out};
          pg8::gemm_phase<pg8::EpiResid, pg8::StaticOrder, true, true>(lds, g, S, E); }
        GRID_BAR();
    }
    if (PH(8)) {
        int lane_f = tid & 63; asm volatile("" : "+v"(lane_f));
        const float* ssq_fin = P_ssq + (size_t)8 * M;
        f32x4 gv[4];
#pragma unroll
        for (int j = 0; j < 4; ++j) gv[j] = ((const f32x4*)P_final_norm)[lane_f + 64 * j];
        float* op = P_out;
        for (int m = gw; m < M; m += 2 * NGW) {
            const int m2 = m + NGW;
            f32x4* xr = (f32x4*)(op + (size_t)m * D) + lane_f; f32x4* xr2 = (f32x4*)(op + (size_t)m2 * D) + lane_f;
            const float rs = pg8::rstd_of(ssq_fin[m]), rs2 = pg8::rstd_of(ssq_fin[m2]);
            f32x4 va[4], vb[4];
#pragma unroll
            for (int j = 0; j < 4; ++j) { va[j] = xr[64 * j]; vb[j] = xr2[64 * j]; }
#pragma unroll
            for (int j = 0; j < 4; ++j) { xr[64 * j] = va[j] * rs * gv[j]; xr2[64 * j] = vb[j] * rs2 * gv[j]; }
        }
    }
}

extern "C" void kernel_launch(void* const* d_in, const int* in_sizes, int n_in, void* d_out, int out_size, void* d_ws, size_t ws_size, hipStream_t stream) {
    static int grid = 0;
    if (grid == 0) {
        if (n_in != 18 || out_size != M * D || ws_size < WS_END) { fprintf(stderr, "kernel_launch: unexpected shapes (n_in %d, out %d, ws %zu)\n", n_in, out_size, ws_size); grid = -1; return; }
        int dev = 0, cus = 0, per_cu = 0;
        hipGetDevice(&dev);
        hipDeviceGetAttribute(&cus, hipDeviceAttributeMultiprocessorCount, dev);
        if (hipFuncSetAttribute((const void*)yoco_fwd, hipFuncAttributeMaxDynamicSharedMemorySize, LDS_BYTES) != hipSuccess) { fprintf(stderr, "kernel_launch: hipFuncSetAttribute failed\n"); grid = -1; return; }
        if (hipOccupancyMaxActiveBlocksPerMultiprocessor(&per_cu, (const void*)yoco_fwd, NWAVES * 64, LDS_BYTES) != hipSuccess || per_cu < 1) { fprintf(stderr, "kernel_launch: occupancy query failed (%d)\n", per_cu); per_cu = 1; }
        (void)hipGetLastError();
        grid = cus * per_cu;
        fprintf(stderr, "kernel_launch: grid %d (cus %d x %d)\n", grid, cus, per_cu);
    }
    if (grid < 0) return;
    Args a{};
    for (int i = 0; i < 18; ++i) a.in[i] = (const float*)d_in[i];
    a.out = (float*)d_out; a.ws = (unsigned char*)d_ws;
    void* kargs[] = {&a};
    hipError_t e = hipLaunchCooperativeKernel((const void*)yoco_fwd, dim3(grid), dim3(NWAVES * 64), kargs, LDS_BYTES, stream);
    if (e != hipSuccess) fprintf(stderr, "kernel_launch: cooperative launch failed: %s (grid %d)\n", hipGetErrorString(e), grid);
}
```

```cpp
#include <hip/hip_runtime.h>
#include <hip/hip_cooperative_groups.h>
#include <cstdio>
#include <cstdint>
namespace cg = cooperative_groups;
namespace pg8 {
#define PG8_LAS __attribute__((address_space(3)))
typedef unsigned short bf16_t;
typedef short bf16x8 __attribute__((ext_vector_type(8)));
typedef float f32x4 __attribute__((ext_vector_type(4)));
typedef unsigned u32x4 __attribute__((ext_vector_type(4)));
constexpr int BM = 256, BK = 64, HALF = 128, HTB = HALF * BK * 2  , STAGE_BYTES = 8 * HTB, NXCD = 8, WGM = 8;

__host__ __device__ __forceinline__ int lds_byte(int r, int c) { const int st = (r >> 4) * 2 + (c >> 5), rr = r & 15, cc = c & 31, ob = rr * 64 + cc * 2; return st * 1024 + (ob ^ (((ob >> 9) & 1) << 5)); }
__host__ __device__ __forceinline__ void stage_rc(int b, int& R, int& C) { const int st = b / 1024, sb = b % 1024, swz = sb ^ (((sb >> 9) & 1) << 5); R = (st >> 1) * 16 + swz / 64; C = (st & 1) * 32 + (swz % 64) / 2; }
__host__ __device__ __forceinline__ int perm32(int rho) { const int n = rho >> 4, i = rho & 15; return 8 * (i >> 2) + 4 * n + (i & 3); }

struct Unit { int pm, pn; };
struct Gemm { const bf16_t* A; const bf16_t* Bt; int M, N, K; };

struct StaticOrder {
    int nM, nN, nwg, G, c;
    __host__ __device__ void init(int M, int N, int G_, int c_) { nM = M / BM; nN = N / BM; nwg = nM * nN; G = G_; c = c_; }
    __host__ __device__ bool next(int i, Unit& u) const {
        const long L = (long)i * G + c; if (L >= nwg) return false;
        int wgid = (int)L; { const int q = nwg / NXCD, r = nwg % NXCD, xcd = wgid % NXCD, off = wgid / NXCD; wgid = (xcd < r ? xcd * (q + 1) : r * (q + 1) + (xcd - r) * q) + off; }
        const int nig = WGM * nN, gid = wgid / nig, fm = gid * WGM, gsz = (nM - fm) < WGM ? (nM - fm) : WGM;
        u.pm = fm + ((wgid % nig) % gsz); u.pn = (wgid % nig) / gsz; return true;
    }
    __device__ __forceinline__ void a_ready(const Unit&) const {}
    __device__ __forceinline__ void done(const Unit&) const {}
};

__device__ __forceinline__ unsigned cvt_pk_bf16(float lo, float hi) { unsigned r; asm volatile("v_cvt_pk_bf16_f32 %0, %1, %2" : "=v"(r) : "v"(lo), "v"(hi)); return r; }
typedef float f32x2 __attribute__((ext_vector_type(2)));
typedef unsigned u32x2 __attribute__((ext_vector_type(2)));
constexpr float RMS_EPS = 1e-5f;
constexpr int DM = 1024, SEQ = 4096, FF = 4096;
__device__ __forceinline__ float rstd_of(float ssq) { return 1.0f / sqrtf(ssq * (1.0f / 1024.0f) + RMS_EPS); }
__device__ __forceinline__ unsigned short bf1(float v) { return (unsigned short)(cvt_pk_bf16(v, 0.f) & 0xffffu); }

struct EpiQKV {
    static constexpr bool PERM = true, AFTER_DRAIN = false;
    bf16_t* Q; bf16_t* K; bf16_t* VT; const float* ssq;
    __device__ __forceinline__ void operator()(const f32x4 (&acc)[2][2][4][2], const Unit& u, int wr, int wc, int fr, int fq) const {
        const int row0 = u.pm * BM + wr * 64 + fr;
        const int t = u.pn >> 2, col0 = (u.pn & 3) * BM + wc * 32 + 8 * fq;
        if (t < 2) {
#pragma unroll
            for (int ai = 0; ai < 2; ++ai)
#pragma unroll
                for (int m = 0; m < 4; ++m) { const int row = row0 + ai * HALF + m * 16; const float rs = rstd_of(ssq[row]);
                    bf16_t* rowp = t == 0 ? Q + (size_t)row * DM + col0 : K + ((size_t)((row >> 12) * 16 + (col0 >> 6)) * SEQ + (row & 4095)) * 64 + (col0 & 63);
                    const size_t bjstep = t == 0 ? (size_t)HALF : (size_t)2 * SEQ * 64;
#pragma unroll
                    for (int bj = 0; bj < 2; ++bj) { const f32x4 v0 = acc[ai][bj][m][0] * rs, v1 = acc[ai][bj][m][1] * rs; u32x4 w;
                        w.x = cvt_pk_bf16(v0[0], v0[1]); w.y = cvt_pk_bf16(v0[2], v0[3]); w.z = cvt_pk_bf16(v1[0], v1[1]); w.w = cvt_pk_bf16(v1[2], v1[3]);
                        *(u32x4*)(rowp + bj * bjstep) = w; } }
        } else {
#pragma unroll
            for (int ai = 0; ai < 2; ++ai)
#pragma unroll
                for (int m = 0; m < 4; ++m) { asm volatile("" ::: "memory"); const int row = row0 + ai * HALF + m * 16; const float rs = rstd_of(ssq[row]); const int b = row >> 12, s = row & 4095;
                    bf16_t* cp = VT + ((((size_t)(b * 16 + (col0 >> 6))) * 128 + (s >> 5)) * 64 + (col0 & 63)) * 32 + (s & 31);
#pragma unroll
                    for (int bj = 0; bj < 2; ++bj)
#pragma unroll
                        for (int n = 0; n < 2; ++n)
#pragma unroll
                            for (int j = 0; j < 4; ++j) cp[(size_t)bj * (2 * 128 * 64 * 32) + (4 * n + j) * 32] = bf1(acc[ai][bj][m][n][j] * rs); }
        }
    }
};

template <bool HAS_KV> struct EpiQB {
    static constexpr bool PERM = true, AFTER_DRAIN = false;
    bf16_t* Q; bf16_t* Ksh; bf16_t* VTsh; const float* bq; const float* bkv; const float* ssq;
    __device__ __forceinline__ void operator()(const f32x4 (&acc)[2][2][4][2], const Unit& u, int wr, int wc, int fr, int fq) const {
        const int row0 = u.pm * BM + wr * 64 + fr;
        if (!HAS_KV || u.pn < 4) {
            const int col0 = u.pn * BM + wc * 32 + 8 * fq;
#pragma unroll
            for (int ai = 0; ai < 2; ++ai)
#pragma unroll
                for (int m = 0; m < 4; ++m) { const int row = row0 + ai * HALF + m * 16; const float rs = rstd_of(ssq[row]); bf16_t* rowp = Q + (size_t)row * DM + col0;
#pragma unroll
                    for (int bj = 0; bj < 2; ++bj) { const f32x4 b0 = *(const f32x4*)(bq + col0 + bj * HALF), b1 = *(const f32x4*)(bq + col0 + bj * HALF + 4);
                        const f32x4 v0 = acc[ai][bj][m][0] * rs + b0, v1 = acc[ai][bj][m][1] * rs + b1; u32x4 w;
                        w.x = cvt_pk_bf16(v0[0], v0[1]); w.y = cvt_pk_bf16(v0[2], v0[3]); w.z = cvt_pk_bf16(v1[0], v1[1]); w.w = cvt_pk_bf16(v1[2], v1[3]);
                        *(u32x4*)(rowp + bj * HALF) = w; }
                    asm volatile("" ::: "memory"); }
        } else {
            const int c0 = wc * 32 + 8 * fq;
#pragma unroll
            for (int ai = 0; ai < 2; ++ai)
#pragma unroll
                for (int m = 0; m < 4; ++m) { const int row = row0 + ai * HALF + m * 16; const float rs = rstd_of(ssq[row]); const int b = row >> 12, s = row & 4095;
                    { const f32x4 b0 = *(const f32x4*)(bkv + c0), b1 = *(const f32x4*)(bkv + c0 + 4);
                      const f32x4 v0 = acc[ai][0][m][0] * rs + b0, v1 = acc[ai][0][m][1] * rs + b1; u32x4 w;
                      w.x = cvt_pk_bf16(v0[0], v0[1]); w.y = cvt_pk_bf16(v0[2], v0[3]); w.z = cvt_pk_bf16(v1[0], v1[1]); w.w = cvt_pk_bf16(v1[2], v1[3]);
                      *(u32x4*)(Ksh + ((size_t)(b * 2 + (c0 >> 6)) * SEQ + s) * 64 + (c0 & 63)) = w; }
                    bf16_t* cp = VTsh + ((((size_t)(b * 2 + (c0 >> 6))) * 128 + (s >> 5)) * 64 + (c0 & 63)) * 32 + (s & 31);
#pragma unroll
                    for (int n = 0; n < 2; ++n) { const f32x4 bb = *(const f32x4*)(bkv + 128 + c0 + 4 * n);
#pragma unroll
                        for (int j = 0; j < 4; ++j) cp[(4 * n + j) * 32] = bf1(acc[ai][1][m][n][j] * rs + bb[j]); }
                    asm volatile("" ::: "memory"); }
        }
    }
};

struct EpiUp {
    static constexpr bool PERM = true, AFTER_DRAIN = false;
    bf16_t* U; const float* ssq;
    __device__ __forceinline__ void operator()(const f32x4 (&acc)[2][2][4][2], const Unit& u, int wr, int wc, int fr, int fq) const {
        const int row0 = u.pm * BM + wr * 64 + fr, col0 = u.pn * BM + wc * 32 + 8 * fq;
#pragma unroll
        for (int ai = 0; ai < 2; ++ai)
#pragma unroll
            for (int m = 0; m < 4; ++m) { const int row = row0 + ai * HALF + m * 16; const float rs = rstd_of(ssq[row]); bf16_t* rowp = U + (size_t)row * FF + col0;
#pragma unroll
                for (int bj = 0; bj < 2; ++bj) { f32x4 v0 = acc[ai][bj][m][0] * rs, v1 = acc[ai][bj][m][1] * rs;
#pragma unroll
                    for (int j = 0; j < 4; ++j) { const float a = fmaxf(v0[j], 0.f), b = fmaxf(v1[j], 0.f); v0[j] = a * a; v1[j] = b * b; }
                    u32x4 w; w.x = cvt_pk_bf16(v0[0], v0[1]); w.y = cvt_pk_bf16(v0[2], v0[3]); w.z = cvt_pk_bf16(v1[0], v1[1]); w.w = cvt_pk_bf16(v1[2], v1[3]);
                    *(u32x4*)(rowp + bj * HALF) = w; } }
    }
};

struct EpiResid {
    static constexpr bool PERM = false, AFTER_DRAIN = false;
    const float* base; float* out; bf16_t* hb; const float* bias; float* ssq_out;
    __device__ __forceinline__ void operator()(const f32x4 (&acc)[2][2][4][2], const Unit& u, int wr, int wc, int fr, int fq) const {
        const int row0 = u.pm * BM + wr * 64 + fr, col0 = u.pn * BM + wc * 32 + 4 * fq;
        f32x4 bv[2][2];
#pragma unroll
        for (int bj = 0; bj < 2; ++bj)
#pragma unroll
            for (int n = 0; n < 2; ++n) bv[bj][n] = bias ? *(const f32x4*)(bias + col0 + bj * HALF + n * 16) : (f32x4){0.f, 0.f, 0.f, 0.f};
#pragma unroll
        for (int ai = 0; ai < 2; ++ai)
#pragma unroll
            for (int m = 0; m < 4; ++m) { const int row = row0 + ai * HALF + m * 16; const size_t off = (size_t)row * DM + col0; float s = 0.f;
#pragma unroll
                for (int bj = 0; bj < 2; ++bj)
#pragma unroll
                    for (int n = 0; n < 2; ++n) { const f32x4 bs = *(const f32x4*)(base + off + bj * HALF + n * 16); const f32x4 v = bs + acc[ai][bj][m][n] + bv[bj][n];
                        *(f32x4*)(out + off + bj * HALF + n * 16) = v; u32x2 w; w.x = cvt_pk_bf16(v[0], v[1]); w.y = cvt_pk_bf16(v[2], v[3]);
                        *(u32x2*)(hb + off + bj * HALF + n * 16) = w; s += (v[0] * v[0] + v[1] * v[1]) + (v[2] * v[2] + v[3] * v[3]); }
                s += __shfl_xor(s, 16); s += __shfl_xor(s, 32);
                if (fq == 0) atomicAdd(ssq_out + row, s);
                asm volatile("" ::: "memory"); }
    }
};

template <class Epi, class Sched, bool ALIGN_EPI = false, bool SP2 = false>
__device__ __forceinline__ void gemm_phase(PG8_LAS unsigned char* lds, const Gemm g, const Sched& S, const Epi& E) {
    int tid_l = threadIdx.x; asm volatile("" : "+v"(tid_l));
    const int tid = tid_l, wid = __builtin_amdgcn_readfirstlane(tid >> 6), lane = tid & 63, wr = wid >> 2, wc = wid & 3, fr = lane & 15, fq = lane >> 4;
    const int K = g.K, nt = K / BK;
    unsigned voffA[2], voffB[2];
#pragma unroll
    for (int i = 0; i < 2; ++i) { int R, C; stage_rc(tid * 16 + i * 8192, R, C); const int Rb = Epi::PERM ? ((R & ~31) + perm32(R & 31)) : R;
        voffA[i] = (unsigned)(R * K + C) * 2u; voffB[i] = (unsigned)(Rb * K + C) * 2u; }
    const size_t kstep = (size_t)(BK * 2);
    const size_t hstep = (size_t)HALF * K * 2;
    const size_t tstep = 2 * hstep;
    const unsigned ldsw = (unsigned)wid * 1024u;
    const int aoff = lds_byte(wr * 64 + fr, fq * 8), boff = lds_byte(wc * 32 + fr, fq * 8);
#define PG8_SA(b, h) (((b) * 2 + (h)) * HTB)
#define PG8_SB(b, h) ((4 + (b) * 2 + (h)) * HTB)
#define PG8_STAGE(bufoff, gbase, voff) do { _Pragma("unroll") for (int _i = 0; _i < 2; ++_i) \
        __builtin_amdgcn_global_load_lds((const unsigned*)((const char*)(gbase) + (voff)[_i]), (PG8_LAS unsigned*)(lds + (bufoff) + ldsw + _i * 8192), 16, 0, 0); } while (0)
#define PG8_LDA(dst, b, h) do { _Pragma("unroll") for (int m = 0; m < 4; ++m) _Pragma("unroll") for (int k = 0; k < 2; ++k) dst[m][k] = *(const PG8_LAS bf16x8*)(lds + PG8_SA(b, h) + aoff + m * 2048 + k * 1024); } while (0)
#define PG8_LDB(dst, b, h) do { _Pragma("unroll") for (int n = 0; n < 2; ++n) _Pragma("unroll") for (int k = 0; k < 2; ++k) dst[n][k] = *(const PG8_LAS bf16x8*)(lds + PG8_SB(b, h) + boff + n * 2048 + k * 1024); } while (0)
#define PG8_MMA(ai, bj, At, Bt) do { __builtin_amdgcn_s_setprio(1); _Pragma("unroll") for (int m = 0; m < 4; ++m) _Pragma("unroll") for (int n = 0; n < 2; ++n) _Pragma("unroll") for (int k = 0; k < 2; ++k) \
        acc[ai][bj][m][n] = __builtin_amdgcn_mfma_f32_16x16x32_bf16(Bt[n][k], At[m][k], acc[ai][bj][m][n], 0, 0, 0); __builtin_amdgcn_s_setprio(0); } while (0)
#define PG8_WAIT_V(n) asm volatile("s_waitcnt vmcnt(" #n ")" ::: "memory")
#define PG8_WAIT_L(n) asm volatile("s_waitcnt lgkmcnt(" #n ")" ::: "memory")
#define PG8_BAR __builtin_amdgcn_s_barrier()
#define PG8_SCHED __builtin_amdgcn_sched_barrier(0)
    Unit cur, nxt; int ui = 0;
    if (!S.next(0, cur)) return;
    f32x4 acc[2][2][4][2];
#pragma unroll
    for (int a = 0; a < 2; ++a)
#pragma unroll
        for (int b = 0; b < 2; ++b)
#pragma unroll
            for (int m = 0; m < 4; ++m)
#pragma unroll
                for (int n = 0; n < 2; ++n) acc[a][b][m][n] = (f32x4){0.f, 0.f, 0.f, 0.f};
    bf16x8 At[4][2], B0[2][2], B1[2][2];
    const char* cA = (const char*)g.A + (size_t)cur.pm * tstep; const char* cB = (const char*)g.Bt + (size_t)cur.pn * tstep;
    S.a_ready(cur);
    if constexpr (SP2) {
        PG8_STAGE(PG8_SB(0, 0), cB, voffB); PG8_STAGE(PG8_SB(0, 1), cB + hstep, voffB); PG8_STAGE(PG8_SA(0, 0), cA, voffA); PG8_STAGE(PG8_SA(0, 1), cA + hstep, voffA);
        if (wr == 1) PG8_BAR;
        PG8_WAIT_V(2); PG8_BAR;
        PG8_STAGE(PG8_SB(1, 0), cB + kstep, voffB); PG8_STAGE(PG8_SA(1, 0), cA + kstep, voffA); PG8_STAGE(PG8_SB(1, 1), cB + hstep + kstep, voffB);
        PG8_WAIT_V(6); PG8_BAR;
    } else {
        PG8_STAGE(PG8_SB(0, 0), cB, voffB); PG8_STAGE(PG8_SA(0, 0), cA, voffA); PG8_STAGE(PG8_SB(0, 1), cB + hstep, voffB); PG8_STAGE(PG8_SA(0, 1), cA + hstep, voffA);
        if (wr == 1) PG8_BAR;
        PG8_WAIT_V(4); PG8_BAR;
        PG8_STAGE(PG8_SB(1, 0), cB + kstep, voffB); PG8_STAGE(PG8_SA(1, 0), cA + kstep, voffA); PG8_STAGE(PG8_SB(1, 1), cB + hstep + kstep, voffB);
        PG8_WAIT_V(6); PG8_BAR;
    }
    for (;;) {
        const bool has_next = S.next(ui + 1, nxt);
        const char* nA = has_next ? (const char*)g.A + (size_t)nxt.pm * tstep : cA; const char* nB = has_next ? (const char*)g.Bt + (size_t)nxt.pn * tstep : cB;
        for (int t = 0; t < nt; t += 2) {
            const bool last = (t == nt - 2);
            const char* a1 = cA + (size_t)(t + 1) * kstep;
            const char* a2 = last ? nA : cA + (size_t)(t + 2) * kstep; const char* b2 = last ? nB : cB + (size_t)(t + 2) * kstep;
            const char* a3 = a2 + kstep; const char* b3 = b2 + kstep;
            if (last && has_next) S.a_ready(nxt);
            if constexpr (SP2) {
            PG8_LDB(B0, 0, 0); PG8_LDB(B1, 0, 1); PG8_SCHED; PG8_LDA(At, 0, 0); PG8_STAGE(PG8_SA(1, 1), a1 + hstep, voffA);
            PG8_WAIT_V(8); PG8_WAIT_L(0); PG8_BAR; PG8_MMA(0, 0, At, B0); PG8_MMA(0, 1, At, B1); PG8_BAR; PG8_SCHED;
            PG8_LDA(At, 0, 1); PG8_STAGE(PG8_SB(0, 0), b2, voffB); PG8_STAGE(PG8_SB(0, 1), b2 + hstep, voffB); PG8_STAGE(PG8_SA(0, 0), a2, voffA);
            PG8_WAIT_V(8); PG8_WAIT_L(0); PG8_BAR; PG8_MMA(1, 0, At, B0); PG8_MMA(1, 1, At, B1); PG8_BAR; PG8_SCHED;
            PG8_LDB(B0, 1, 0); PG8_LDB(B1, 1, 1); PG8_SCHED; PG8_LDA(At, 1, 0); PG8_STAGE(PG8_SA(0, 1), a2 + hstep, voffA);
            PG8_WAIT_V(8); PG8_WAIT_L(0); PG8_BAR; PG8_MMA(0, 0, At, B0); PG8_MMA(0, 1, At, B1); PG8_BAR; PG8_SCHED;
            PG8_LDA(At, 1, 1); PG8_STAGE(PG8_SB(1, 0), b3, voffB); PG8_STAGE(PG8_SB(1, 1), b3 + hstep, voffB); PG8_STAGE(PG8_SA(1, 0), a3, voffA);
            PG8_WAIT_V(8); PG8_WAIT_L(0); PG8_BAR; PG8_MMA(1, 0, At, B0); PG8_MMA(1, 1, At, B1); PG8_BAR; PG8_SCHED;
            } else {
            PG8_LDB(B0, 0, 0); PG8_SCHED; PG8_LDA(At, 0, 0); PG8_STAGE(PG8_SA(1, 1), a1 + hstep, voffA);
            PG8_WAIT_L(8); PG8_BAR; PG8_WAIT_L(0); PG8_MMA(0, 0, At, B0); PG8_BAR; PG8_SCHED;
            PG8_LDB(B1, 0, 1); PG8_STAGE(PG8_SB(0, 0), b2, voffB);
            PG8_BAR; PG8_WAIT_L(0); PG8_MMA(0, 1, At, B1); PG8_BAR;
            PG8_LDA(At, 0, 1); PG8_STAGE(PG8_SA(0, 0), a2, voffA);
            PG8_BAR; PG8_WAIT_L(0); PG8_MMA(1, 0, At, B0); PG8_BAR; PG8_SCHED;
            PG8_STAGE(PG8_SB(0, 1), b2 + hstep, voffB);
            PG8_WAIT_V(6); PG8_BAR; PG8_MMA(1, 1, At, B1); PG8_BAR;
            PG8_LDB(B0, 1, 0); PG8_SCHED; PG8_LDA(At, 1, 0); PG8_STAGE(PG8_SA(0, 1), a2 + hstep, voffA);
            PG8_WAIT_L(8); PG8_BAR; PG8_WAIT_L(0); PG8_MMA(0, 0, At, B0); PG8_BAR; PG8_SCHED;
            PG8_LDB(B1, 1, 1); PG8_STAGE(PG8_SB(1, 0), b3, voffB);
            PG8_BAR; PG8_WAIT_L(0); PG8_MMA(0, 1, At, B1); PG8_BAR;
            PG8_LDA(At, 1, 1); PG8_STAGE(PG8_SA(1, 0), a3, voffA);
            PG8_BAR; PG8_WAIT_L(0); PG8_MMA(1, 0, At, B0); PG8_BAR; PG8_SCHED;
            PG8_STAGE(PG8_SB(1, 1), b3 + hstep, voffB);
            PG8_WAIT_V(6); PG8_BAR; PG8_MMA(1, 1, At, B1); PG8_BAR;
            }
        }
        if constexpr (ALIGN_EPI) { if (wr == 0) PG8_BAR; }
        if constexpr (!Epi::AFTER_DRAIN) { E(acc, cur, wr, wc, fr, fq); S.done(cur); }
        if (!has_next) break;
#pragma unroll
        for (int a = 0; a < 2; ++a)
#pragma unroll
            for (int b = 0; b < 2; ++b)
#pragma unroll
                for (int m = 0; m < 4; ++m)
#pragma unroll
                    for (int n = 0; n < 2; ++n) acc[a][b][m][n] = (f32x4){0.f, 0.f, 0.f, 0.f};
        cur = nxt; cA = nA; cB = nB; ++ui;
        if constexpr (ALIGN_EPI) { if (wr == 1) PG8_BAR; }
    }
    PG8_WAIT_V(0);
    if constexpr (!ALIGN_EPI) { if (wr == 0) PG8_BAR; }
    PG8_BAR;
    if constexpr (Epi::AFTER_DRAIN) { E.fused(acc, cur, wr, wc, fr, fq, lds, wid, lane); S.done(cur); }
#undef PG8_SA
#undef PG8_SB
#undef PG8_STAGE
#undef PG8_LDA
#undef PG8_LDB
#undef PG8_MMA
#undef PG8_WAIT_V
#undef PG8_WAIT_L
#undef PG8_BAR
#undef PG8_SCHED
}
}

#define LAS __attribute__((address_space(3)))
typedef unsigned short bf16;
typedef unsigned v4u __attribute__((ext_vector_type(4)));
typedef unsigned v2u __attribute__((ext_vector_type(2)));
typedef float f32x4 __attribute__((ext_vector_type(4)));
typedef float f32x16 __attribute__((ext_vector_type(16)));
typedef short bf16x8 __attribute__((ext_vector_type(8)));
using pg8::cvt_pk_bf16;

constexpr int NWAVES = 8;
constexpr int BATCH = 8, SEQ = 4096, D = 1024, FF = 4096, M = BATCH * SEQ;
constexpr size_t MiB = 1u << 20;
constexpr size_t WS_SSQ = 0;
constexpr size_t WS_BAR = 1280 * 1024;
constexpr size_t WS_TAB = 1536 * 1024;
constexpr size_t WS_WA_QKV = 2 * MiB, WS_WA_O = 8 * MiB, WA_STRIDE = 8 * MiB;
constexpr size_t WS_WB_Q0 = 18 * MiB;
constexpr size_t WS_WB_Q1 = 21 * MiB;
constexpr size_t WS_WB_O = 23 * MiB;
constexpr size_t WS_WUP = 27 * MiB, WS_WDN = 35 * MiB, WM_STRIDE = 16 * MiB;
constexpr size_t WS_HB = 92 * MiB;
constexpr size_t WS_KSH = 156 * MiB, WS_VTSH = 164 * MiB;
constexpr size_t WS_BIG = 172 * MiB;
constexpr size_t WS_END = 428 * MiB;
constexpr int LDS_BYTES = 147456;

__device__ __forceinline__ float wave_sum(float v) {
#pragma unroll
    for (int o = 1; o < 64; o <<= 1) v += __shfl_xor(v, o);
    return v;
}
typedef float f32x2_t __attribute__((ext_vector_type(2))); typedef __bf16 bf16x2_t __attribute__((ext_vector_type(2)));
__device__ __forceinline__ unsigned pk2(float lo, float hi) { f32x2_t v = {lo, hi}; bf16x2_t b = __builtin_convertvector(v, bf16x2_t); return __builtin_bit_cast(unsigned, b); }

__device__ __forceinline__ void transpose_item(const float* W, const float* gain, int K, int N, bf16* WT, int row_off, LAS float* scr, int item, int lane) {
    const int nblk = N / 32, kb = item / nblk, nb = item % nblk, k0 = 64 * kb, n0 = 32 * nb;
    const float* wp = W + (size_t)(k0 + (lane >> 5)) * N + n0 + (lane & 31);
    float v[32];
#pragma unroll
    for (int i = 0; i < 32; ++i) v[i] = wp[(size_t)(2 * i) * N];
    const int c = lane & 7;
    f32x4 g0 = {1.f, 1.f, 1.f, 1.f}, g1 = {1.f, 1.f, 1.f, 1.f};
    if (gain) { g0 = *(const f32x4*)(gain + k0 + 8 * c); g1 = *(const f32x4*)(gain + k0 + 8 * c + 4); }
#pragma unroll
    for (int i = 0; i < 32; ++i) scr[(2 * i + (lane >> 5)) * 33 + (lane & 31)] = v[i];
    asm volatile("s_waitcnt lgkmcnt(0)" ::: "memory");
#pragma unroll
    for (int j = 0; j < 4; ++j) { const int n = (lane >> 3) + 8 * j; const LAS float* s = scr + (8 * c) * 33 + n;
        v4u o; o.x = pk2(s[0 * 33] * g0.x, s[1 * 33] * g0.y); o.y = pk2(s[2 * 33] * g0.z, s[3 * 33] * g0.w); o.z = pk2(s[4 * 33] * g1.x, s[5 * 33] * g1.y); o.w = pk2(s[6 * 33] * g1.z, s[7 * 33] * g1.w);
        *(v4u*)(WT + (size_t)(row_off + n0 + n) * K + k0 + 8 * c) = o; }
    asm volatile("s_waitcnt lgkmcnt(0)" ::: "memory");
}

__device__ __forceinline__ int pi32(int m) { return (m & ~12) | ((m & 4) << 1) | ((m & 8) >> 1); }
#define MFMA32(a, b, c) __builtin_amdgcn_mfma_f32_32x32x16_bf16((a), (b), (c), 0, 0, 0)
constexpr float LOG2E = 1.4426950408889634f, LN2 = 0.6931471805599453f;

__device__ __forceinline__ void sb_attn_phase(const bf16* Q, const bf16* K, const bf16* VT, bf16* O, int gw, int ngw, int lane_in) {
    int lane = lane_in; asm volatile("" : "+v"(lane));
    const int ql = lane & 31, hi = lane >> 5, kperm = pi32(ql);
    for (int unit = gw; unit < BATCH * 16 * (SEQ / 32); unit += ngw) {
        const int qt = unit & 127, bh = unit >> 7, h = bh & 15, b = bh >> 4, q0 = qt * 32, t = q0 + ql;
        const size_t tok0 = (size_t)b * SEQ;
        const bf16* qp = Q + (tok0 + q0 + ql) * D + h * 64 + 8 * hi;
        bf16x8 qf[4];
#pragma unroll
        for (int kk = 0; kk < 4; ++kk) qf[kk] = *(const bf16x8*)(qp + 16 * kk);
        f32x16 o0, o1;
#pragma unroll
        for (int r = 0; r < 16; ++r) { o0[r] = 0.f; o1[r] = 0.f; }
        float carry = 0.f;
        const bf16* kbase = K + ((size_t)(b * 16 + h) * SEQ + kperm) * 64 + 8 * hi;
        const bf16* vbase = VT + (((size_t)(b * 16 + h) * 128) * 64 + ql) * 32 + 8 * hi;
        bf16x8 kf[4], vf[2][2], kn[4], vn[2][2];
        { const int k0 = q0;
#pragma unroll
          for (int kk = 0; kk < 4; ++kk) kf[kk] = *(const bf16x8*)(kbase + (size_t)k0 * 64 + 16 * kk);
#pragma unroll
          for (int dh = 0; dh < 2; ++dh)
#pragma unroll
              for (int a = 0; a < 2; ++a) vf[dh][a] = *(const bf16x8*)(vbase + (size_t)k0 * 64 + (32 * dh) * 32 + 16 * a); }
        for (int jb = qt; jb >= 0; --jb) {
            const int k0 = jb * 32;
            if (jb > 0) {
                const int k1 = k0 - 32;
#pragma unroll
                for (int kk = 0; kk < 4; ++kk) kn[kk] = *(const bf16x8*)(kbase + (size_t)k1 * 64 + 16 * kk);
#pragma unroll
                for (int dh = 0; dh < 2; ++dh)
#pragma unroll
                    for (int a = 0; a < 2; ++a) vn[dh][a] = *(const bf16x8*)(vbase + (size_t)k1 * 64 + (32 * dh) * 32 + 16 * a);
            }
            f32x16 p;
#pragma unroll
            for (int r = 0; r < 16; ++r) p[r] = 0.f;
#pragma unroll
            for (int kk = 0; kk < 4; ++kk) p = MFMA32(kf[kk], qf[kk], p);
            float L[2][8], ls[2][8], cs[2], pcs[2];
#pragma unroll
            for (int a = 0; a < 2; ++a) { float acc = 0.f;
#pragma unroll
                for (int i = 0; i < 8; ++i) {
                    const float z = p[8 * a + i] * (0.125f * LOG2E);
                    const bool valid = (k0 + 16 * a + 8 * hi + i) < t;
                    const float sp = __builtin_amdgcn_logf(1.0f + __builtin_amdgcn_exp2f(-fabsf(z)));
                    L[a][i] = valid ? -(fmaxf(z, 0.f) + sp) : 0.f;
                    ls[a][i] = valid ? (fminf(z, 0.f) - sp) : -1e30f;
                    acc += L[a][i]; }
                cs[a] = acc; }
#pragma unroll
            for (int a = 0; a < 2; ++a) pcs[a] = __shfl_xor(cs[a], 32);
            float run = carry;
            bf16x8 wf[2];
#pragma unroll
            for (int a = 1; a >= 0; --a) {
                float r_ = run + (hi == 0 ? pcs[a] : 0.f);
                float w[8];
#pragma unroll
                for (int i = 7; i >= 0; --i) { w[i] = __builtin_amdgcn_exp2f(ls[a][i] + r_); r_ += L[a][i]; }
                v4u pk; pk.x = pk2(w[0], w[1]); pk.y = pk2(w[2], w[3]); pk.z = pk2(w[4], w[5]); pk.w = pk2(w[6], w[7]);
                wf[a] = __builtin_bit_cast(bf16x8, pk);
                run += cs[a] + pcs[a]; }
            carry = run;
#pragma unroll
            for (int a = 0; a < 2; ++a) { o0 = MFMA32(vf[0][a], wf[a], o0); o1 = MFMA32(vf[1][a], wf[a], o1); }
            if (__all(carry < -104.0f * LOG2E)) break;
#pragma unroll
            for (int kk = 0; kk < 4; ++kk) kf[kk] = kn[kk];
#pragma unroll
            for (int dh = 0; dh < 2; ++dh)
#pragma unroll
                for (int a = 0; a < 2; ++a) vf[dh][a] = vn[dh][a];
        }
        bf16* op = O + (tok0 + q0 + ql) * D + h * 64 + 4 * hi;
#pragma unroll
        for (int g = 0; g < 4; ++g) {
            v2u a; a.x = pk2(o0[4 * g], o0[4 * g + 1]); a.y = pk2(o0[4 * g + 2], o0[4 * g + 3]); *(v2u*)(op + 8 * g) = a;
            v2u c; c.x = pk2(o1[4 * g], o1[4 * g + 1]); c.y = pk2(o1[4 * g + 2], o1[4 * g + 3]); *(v2u*)(op + 32 + 8 * g) = c; }
    }
}

__device__ __forceinline__ void swa_attn_phase(const bf16* Q, const bf16* Ksh, const bf16* VTsh, bf16* O, const float* sinks, const LAS float* tab, int gw, int ngw, int lane_in) {
    int lane = lane_in; asm volatile("" : "+v"(lane));
    const int ql = lane & 31, hi = lane >> 5, kperm = pi32(ql);
    for (int unit = gw; unit < BATCH * 16 * (SEQ / 32); unit += ngw) {
        const int qt = unit & 127, bh = unit >> 7, qh = bh & 15, b = bh >> 4, kvh = qh >> 3, q0 = qt * 32, t = q0 + ql;
        const size_t tok0 = (size_t)b * SEQ;
        const bf16* qp = Q + (tok0 + q0 + ql) * D + qh * 64 + 8 * hi;
        bf16x8 qf[4];
#pragma unroll
        for (int kk = 0; kk < 4; ++kk) qf[kk] = *(const bf16x8*)(qp + 16 * kk);
        const float sink = sinks[qh];
        const LAS float* tb = tab + qh * 128;
        bf16x8 kf[5][4], vf[5][2][2];
        const bf16* vbase = VTsh + (((size_t)(b * 2 + kvh) * 128) * 64 + ql) * 32 + 8 * hi;
#pragma unroll
        for (int j = 0; j < 5; ++j) {
            const int k0 = q0 - 128 + 32 * j;
            if (k0 >= 0) {
                const bf16* kp = Ksh + ((size_t)(b * 2 + kvh) * SEQ + k0 + kperm) * 64 + 8 * hi;
#pragma unroll
                for (int kk = 0; kk < 4; ++kk) kf[j][kk] = *(const bf16x8*)(kp + 16 * kk);
            } else {
#pragma unroll
                for (int kk = 0; kk < 4; ++kk) kf[j][kk] = (bf16x8){0, 0, 0, 0, 0, 0, 0, 0};
            }
        }
        f32x16 p[5];
        float mx = sink;
#pragma unroll
        for (int j = 0; j < 5; ++j) {
#pragma unroll
            for (int r = 0; r < 16; ++r) p[j][r] = 0.f;
#pragma unroll
            for (int kk = 0; kk < 4; ++kk) p[j] = MFMA32(kf[j][kk], qf[kk], p[j]);
        }
        __builtin_amdgcn_sched_barrier(0);
#pragma unroll
        for (int j = 0; j < 5; ++j) {
            const int k0 = q0 - 128 + 32 * j;
            if (k0 >= 0) {
#pragma unroll
                for (int a = 0; a < 2; ++a) { vf[j][a][0] = *(const bf16x8*)(vbase + (size_t)k0 * 64 + 16 * a); vf[j][a][1] = *(const bf16x8*)(vbase + (size_t)k0 * 64 + 32 * 32 + 16 * a); }
            } else {
#pragma unroll
                for (int a = 0; a < 2; ++a) { vf[j][a][0] = (bf16x8){0, 0, 0, 0, 0, 0, 0, 0}; vf[j][a][1] = (bf16x8){0, 0, 0, 0, 0, 0, 0, 0}; }
            }
        }
#pragma unroll
        for (int j = 0; j < 5; ++j) {
            const int k0 = q0 - 128 + 32 * j;
#pragma unroll
            for (int r = 0; r < 16; ++r) {
                const int dist = t - (k0 + 16 * (r >> 3) + 8 * hi + (r & 7));
                const bool valid = (k0 >= 0) && dist >= 0 && dist < 128;
                const float s = valid ? (p[j][r] * 0.125f + tb[dist & 127]) : -1e30f;
                p[j][r] = s; mx = fmaxf(mx, s); }
        }
        mx = fmaxf(mx, __shfl_xor(mx, 32));
        float sum = 0.f;
        bf16x8 pf[5][2];
#pragma unroll
        for (int j = 0; j < 5; ++j) {
            float e[16];
#pragma unroll
            for (int r = 0; r < 16; ++r) { e[r] = __builtin_amdgcn_exp2f((p[j][r] - mx) * LOG2E); sum += e[r]; }
#pragma unroll
            for (int a = 0; a < 2; ++a) { v4u pk; pk.x = pk2(e[8 * a], e[8 * a + 1]); pk.y = pk2(e[8 * a + 2], e[8 * a + 3]); pk.z = pk2(e[8 * a + 4], e[8 * a + 5]); pk.w = pk2(e[8 * a + 6], e[8 * a + 7]);
                pf[j][a] = __builtin_bit_cast(bf16x8, pk); }
        }
        sum += __shfl_xor(sum, 32);
        sum += __builtin_amdgcn_exp2f((sink - mx) * LOG2E);
        const float inv = 1.0f / sum;
        f32x16 o0, o1;
#pragma unroll
        for (int r = 0; r < 16; ++r) { o0[r] = 0.f; o1[r] = 0.f; }
#pragma unroll
        for (int j = 0; j < 5; ++j)
#pragma unroll
            for (int a = 0; a < 2; ++a) { o0 = MFMA32(vf[j][a][0], pf[j][a], o0); o1 = MFMA32(vf[j][a][1], pf[j][a], o1); }
        bf16* op = O + (tok0 + q0 + ql) * D + qh * 64 + 4 * hi;
#pragma unroll
        for (int g = 0; g < 4; ++g) {
            v2u a; a.x = pk2(o0[4 * g] * inv, o0[4 * g + 1] * inv); a.y = pk2(o0[4 * g + 2] * inv, o0[4 * g + 3] * inv); *(v2u*)(op + 8 * g) = a;
            v2u c; c.x = pk2(o1[4 * g] * inv, o1[4 * g + 1] * inv); c.y = pk2(o1[4 * g + 2] * inv, o1[4 * g + 3] * inv); *(v2u*)(op + 32 + 8 * g) = c; }
    }
}


__device__ __forceinline__ float bf2f(bf16 v) { return __uint_as_float((unsigned)v << 16); }
__device__ __forceinline__ void sb_attn_naive(const bf16* Q, const bf16* K, const bf16* VT, bf16* O, int gtid_in, int gthreads) {
    int gtid = gtid_in; asm volatile("" : "+v"(gtid));
    for (int idx = gtid; idx < BATCH * 16 * SEQ; idx += gthreads) {
        const int t = idx & 4095, bh = idx >> 12, h = bh & 15, b = bh >> 4;
        const size_t tok0 = (size_t)b * SEQ;
        float o[64]; const bf16* q = Q + (tok0 + t) * D + h * 64;
#pragma unroll
        for (int d = 0; d < 64; ++d) o[d] = 0.f;
        float carry = 0.f;
        for (int s = t - 1; s >= 0; --s) {
            float z = 0.f;
#pragma unroll
            for (int d = 0; d < 64; ++d) z += bf2f(q[d]) * bf2f(K[(tok0 + s) * D + h * 64 + d]);
            z *= 0.125f;
            const float sp = __builtin_amdgcn_logf(1.0f + __builtin_amdgcn_exp2f(-fabsf(z) * 1.4426950408889634f)) * 0.6931471805599453f;
            const float w = __builtin_amdgcn_exp2f((fminf(z, 0.f) - sp + carry) * 1.4426950408889634f);
            carry += -(fmaxf(z, 0.f) + sp);
#pragma unroll
            for (int d = 0; d < 64; ++d) o[d] += w * bf2f(VT[((size_t)(b * D + h * 64 + d)) * SEQ + s]);
            if (carry < -104.f) break;
        }
#pragma unroll
        for (int d = 0; d < 64; ++d) O[(tok0 + t) * D + h * 64 + d] = pg8::bf1(o[d]);
    }
}
__device__ __forceinline__ void swa_attn_naive(const bf16* Q, const bf16* Ksh, const bf16* VTsh, bf16* O, const float* sinks, const float* tabg, int gtid_in, int gthreads) {
    int gtid = gtid_in; asm volatile("" : "+v"(gtid));
    for (int idx = gtid; idx < BATCH * 16 * SEQ; idx += gthreads) {
        const int t = idx & 4095, bh = idx >> 12, qh = bh & 15, b = bh >> 4, kvh = qh >> 3;
        const size_t tok0 = (size_t)b * SEQ;
        float o[64]; const bf16* q = Q + (tok0 + t) * D + qh * 64;
#pragma unroll
        for (int d = 0; d < 64; ++d) o[d] = 0.f;
        const float sink = sinks[qh];
        float mx = sink, sum = 0.f;
        const int s_lo = t - 127 > 0 ? t - 127 : 0;
        for (int s = s_lo; s <= t; ++s) {
            float z = 0.f;
#pragma unroll
            for (int d = 0; d < 64; ++d) z += bf2f(q[d]) * bf2f(Ksh[(tok0 + s) * 128 + kvh * 64 + d]);
            z = z * 0.125f + tabg[qh * 128 + (t - s)];
            const float nm = fmaxf(mx, z), sc = __builtin_amdgcn_exp2f((mx - nm) * 1.4426950408889634f), e = __builtin_amdgcn_exp2f((z - nm) * 1.4426950408889634f);
            sum = sum * sc + e; mx = nm;
#pragma unroll
            for (int d = 0; d < 64; ++d) o[d] = o[d] * sc + e * bf2f(VTsh[((size_t)(b * 128 + kvh * 64 + d)) * SEQ + s]);
        }
        sum += __builtin_amdgcn_exp2f((sink - mx) * 1.4426950408889634f);
        const float inv = 1.0f / sum;
#pragma unroll
        for (int d = 0; d < 64; ++d) O[(tok0 + t) * D + qh * 64 + d] = pg8::bf1(o[d] * inv);
    }
}
#define XB_TMO      128
#define XB_XCNT(j)  (256  + 64 * (j))
#define XB_XSUB(j)  (1280 + 64 * (j))
#define XB_XGEN(j)  (2304 + 64 * (j))
#define XB_TOP      3328
#define XB_TOPGEN   3392
#define XCD_BAR_WORDS 3456
#define XB_SPIN_CAP (1u << 18)

__device__ __forceinline__ unsigned xb_ld(unsigned* p)              { return __hip_atomic_load(p, __ATOMIC_RELAXED, __HIP_MEMORY_SCOPE_AGENT); }
__device__ __forceinline__ unsigned xb_add(unsigned* p, unsigned v) { return __hip_atomic_fetch_add(p, v, __ATOMIC_RELAXED, __HIP_MEMORY_SCOPE_AGENT); }
__device__ __forceinline__ unsigned xb_xcc_id() { return (unsigned)__builtin_amdgcn_s_getreg((3 << 11) | 20) & 0xFu; }
#define XB_SPIN(cond, bar) do { unsigned _sp = 0; while (cond) { __builtin_amdgcn_s_sleep(1); \
    if ((++_sp & 255u) == 0u) { if (xb_ld(&(bar)[XB_TMO])) break; if (_sp > XB_SPIN_CAP) { atomicAdd(&(bar)[XB_TMO], 1u); break; } } } } while (0)

struct XcdBarrier {
    unsigned* bar; unsigned x;
    volatile LAS unsigned* st;
};

__device__ __forceinline__ XcdBarrier xcd_barrier_post(unsigned* bar, volatile LAS unsigned* st) {
    XcdBarrier b; b.bar = bar; b.x = xb_xcc_id(); b.st = st;
    if (threadIdx.x == 0) (void)xb_add(&bar[XB_XCNT(b.x)], 1u);
    return b;
}
__device__ __forceinline__ void xcd_barrier_complete(unsigned* bar, unsigned x, unsigned& nloc, unsigned& nx) {
    const unsigned G = gridDim.x * gridDim.y * gridDim.z;
    unsigned sum, cnt, mine, sp = 0u;
    for (;;) {
        sum = 0u; cnt = 0u; mine = 0u;
#pragma unroll
        for (unsigned j = 0; j < 16; ++j) { const unsigned c = xb_ld(&bar[XB_XCNT(j)]); sum += c; cnt += (c > 0u) ? 1u : 0u; mine = (j == x) ? c : mine; }
        if (sum == G) break;
        __builtin_amdgcn_s_sleep(1);
        if ((++sp & 255u) == 0u) { if (xb_ld(&bar[XB_TMO])) break; if (sp > XB_SPIN_CAP) { atomicAdd(&bar[XB_TMO], 1u); break; } }
    }
    nloc = mine > 0u ? mine : 1u; nx = cnt > 0u ? cnt : 1u;
}

__device__ __forceinline__ void xcd_barrier(const XcdBarrier& b) {
    asm volatile("s_waitcnt vmcnt(0)" ::: "memory");
    __syncthreads();
    if (threadIdx.x == 0) {
        unsigned* bar = b.bar;
        __builtin_amdgcn_s_waitcnt(0);
        unsigned nloc = b.st[0], nx = b.st[1];
        if (nloc == 0u) { xcd_barrier_complete(bar, b.x, nloc, nx); b.st[0] = nloc; b.st[1] = nx; }
        const unsigned old = xb_add(&bar[XB_XSUB(b.x)], 1u);
        const unsigned gen = old / nloc;
        if (old + 1u == (gen + 1u) * nloc) {
            __builtin_amdgcn_fence(__ATOMIC_RELEASE, "agent");
            asm volatile("s_waitcnt vmcnt(0)" ::: "memory");
            const unsigned og = xb_add(&bar[XB_TOP], 1u);
            const unsigned tg = og / nx;
            if (og + 1u == (tg + 1u) * nx) xb_add(&bar[XB_TOPGEN], 1u);
            else XB_SPIN(xb_ld(&bar[XB_TOPGEN]) == tg, bar);
            __builtin_amdgcn_fence(__ATOMIC_ACQUIRE, "agent");
            xb_add(&bar[XB_XGEN(b.x)], 1u);
            asm volatile("s_waitcnt vmcnt(0)" ::: "memory");
        } else {
            XB_SPIN(xb_ld(&bar[XB_XGEN(b.x)]) == gen, bar);
            __builtin_amdgcn_fence(__ATOMIC_ACQUIRE, "agent");
            asm volatile("s_waitcnt vmcnt(0)" ::: "memory");
        }
    }
    __syncthreads();
}

#ifndef REP_PRO
#define REP_PRO 1
#endif
#ifndef REP_QKV
#define REP_QKV 1
#endif
#ifndef REP_SB
#define REP_SB 1
#endif
#ifndef REP_SWA
#define REP_SWA 1
#endif
#ifndef REP_UP
#define REP_UP 1
#endif
#ifndef EXTRA_SYNC
#define EXTRA_SYNC 0
#endif
#ifndef ONLY
#define ONLY -1
#endif
#define PH(n) (ONLY < 0 || ONLY == (n))
struct Args { const float* in[18]; float* out; unsigned char* ws; };

__global__ void __launch_bounds__(NWAVES * 64, 2) yoco_fwd(Args args) {
    extern __shared__ __attribute__((aligned(16))) unsigned char lds_raw[];
    cg::grid_group grid = cg::this_grid();
    LAS unsigned char* lds = (LAS unsigned char*)lds_raw;
    const int tid = threadIdx.x, lane = tid & 63, wave = __builtin_amdgcn_readfirstlane(tid >> 6);
    const int G = gridDim.x, bx = blockIdx.x;
    const int vcu = (G % 8 == 0) ? (bx % 8) * (G / 8) + bx / 8 : bx;
    const int gw = vcu * NWAVES + wave, NGW = G * NWAVES;
    volatile LAS unsigned long long* slots = (volatile LAS unsigned long long*)(lds + 131072 + 2048);
    if (tid == 0) {
#pragma unroll
        for (int i = 0; i < 18; ++i) slots[i] = (unsigned long long)args.in[i];
        slots[18] = (unsigned long long)args.out; slots[19] = (unsigned long long)args.ws;
    }
    __syncthreads();
#define GP(i) ((const float*)(((unsigned long long)(unsigned)__builtin_amdgcn_readfirstlane((unsigned)(slots[i] >> 32)) << 32) | (unsigned long long)(unsigned)__builtin_amdgcn_readfirstlane((unsigned)slots[i])))
#define P_x GP(0)
#define P_a_norm GP(1)
#define P_a_wqkv GP(2)
#define P_a_wo GP(3)
#define P_kv_norm GP(4)
#define P_w_kv GP(5)
#define P_b_kv GP(6)
#define P_b_norm GP(7)
#define P_b_wq GP(8)
#define P_b_bq GP(9)
#define P_b_sinks GP(10)
#define P_b_wo GP(11)
#define P_b_bo GP(12)
#define P_rel_bias GP(13)
#define P_mlp_norm GP(14)
#define P_mlp_up GP(15)
#define P_mlp_down GP(16)
#define P_final_norm GP(17)
#define P_out ((float*)GP(18))
#define P_ws ((unsigned char*)GP(19))
#define P_ssq ((float*)(P_ws + WS_SSQ))
#define P_tabg ((float*)(P_ws + WS_TAB))
#define P_HB ((bf16*)(P_ws + WS_HB))
#define P_KSH ((bf16*)(P_ws + WS_KSH))
#define P_VTSH ((bf16*)(P_ws + WS_VTSH))
#define P_U ((bf16*)(P_ws + WS_BIG))
#define P_Qb ((bf16*)(P_ws + WS_BIG))
#define P_Kb ((bf16*)(P_ws + WS_BIG + 64 * MiB))
#define P_VTb ((bf16*)(P_ws + WS_BIG + 128 * MiB))
#define P_Ob ((bf16*)(P_ws + WS_BIG + 192 * MiB))

    for (int rep = 0; rep < REP_PRO; ++rep) if (PH(0)) {
        LAS float* scr = (LAS float*)(lds + wave * 16384);
        constexpr int I_QKV = (D / 64) * (3 * D / 32), I_DD = (D / 64) * (D / 32), I_KV = (D / 64) * (256 / 32), I_UP = (D / 64) * (FF / 32), I_DN = (FF / 64) * (D / 32);
        constexpr int NITEMS = 2 * (I_QKV + I_DD) + (I_DD + I_KV) + I_DD + 2 * I_DD + 4 * (I_UP + I_DN);
        for (int it = gw; it < NITEMS; it += NGW) {
            int r = it; bool done = false;
#pragma unroll
            for (int l = 0; l < 2; ++l) {
                if (!done && r < I_QKV) { transpose_item(P_a_wqkv + (size_t)l * D * 3 * D, P_a_norm + l * D, D, 3 * D, (bf16*)(P_ws + WS_WA_QKV + l * WA_STRIDE), 0, scr, r, lane); done = true; } if (!done) r -= I_QKV;
                if (!done && r < I_DD) { transpose_item(P_a_wo + (size_t)l * D * D, nullptr, D, D, (bf16*)(P_ws + WS_WA_O + l * WA_STRIDE), 0, scr, r, lane); done = true; } if (!done) r -= I_DD;
            }
            if (!done && r < I_DD) { transpose_item(P_b_wq, P_b_norm, D, D, (bf16*)(P_ws + WS_WB_Q0), 0, scr, r, lane); done = true; } if (!done) r -= I_DD;
            if (!done && r < I_KV) { transpose_item(P_w_kv, P_kv_norm, D, 256, (bf16*)(P_ws + WS_WB_Q0), 1024, scr, r, lane); done = true; } if (!done) r -= I_KV;
            if (!done && r < I_DD) { transpose_item(P_b_wq + (size_t)D * D, P_b_norm + D, D, D, (bf16*)(P_ws + WS_WB_Q1), 0, scr, r, lane); done = true; } if (!done) r -= I_DD;
#pragma unroll
            for (int j = 0; j < 2; ++j) { if (!done && r < I_DD) { transpose_item(P_b_wo + (size_t)j * D * D, nullptr, D, D, (bf16*)(P_ws + WS_WB_O + j * 2 * MiB), 0, scr, r, lane); done = true; } if (!done) r -= I_DD; }
#pragma unroll
            for (int l = 0; l < 4; ++l) {
                if (!done && r < I_UP) { transpose_item(P_mlp_up + (size_t)l * D * FF, P_mlp_norm + l * D, D, FF, (bf16*)(P_ws + WS_WUP + l * WM_STRIDE), 0, scr, r, lane); done = true; } if (!done) r -= I_UP;
                if (!done && r < I_DN) { transpose_item(P_mlp_down + (size_t)l * FF * D, nullptr, FF, D, (bf16*)(P_ws + WS_WDN + l * WM_STRIDE), 0, scr, r, lane); done = true; } if (!done) r -= I_DN;
            }
        }
        { const float* xp = P_x; bf16* hbp = P_HB; float* sq = P_ssq;
          for (int m = gw; m < M; m += 2 * NGW) {
            const int m2 = m + NGW;
            const f32x4* xr = (const f32x4*)(xp + (size_t)m * D) + lane; const f32x4* xr2 = (const f32x4*)(xp + (size_t)m2 * D) + lane;
            f32x4 va[4], vb[4];
#pragma unroll
            for (int j = 0; j < 4; ++j) { va[j] = xr[64 * j]; vb[j] = xr2[64 * j]; }
            unsigned long long* o8 = (unsigned long long*)(hbp + (size_t)m * D) + lane; unsigned long long* o82 = (unsigned long long*)(hbp + (size_t)m2 * D) + lane;
            float s = 0.f, s2 = 0.f;
#pragma unroll
            for (int j = 0; j < 4; ++j) { const f32x4 v = va[j], w = vb[j];
                s += (v.x * v.x + v.y * v.y) + (v.z * v.z + v.w * v.w); s2 += (w.x * w.x + w.y * w.y) + (w.z * w.z + w.w * w.w);
                o8[64 * j] = (unsigned long long)pk2(v.x, v.y) | ((unsigned long long)pk2(v.z, v.w) << 32);
                o82[64 * j] = (unsigned long long)pk2(w.x, w.y) | ((unsigned long long)pk2(w.z, w.w) << 32); }
            s = wave_sum(s); s2 = wave_sum(s2);
            if (lane == 0) { sq[m] = s; sq[m2] = s2; }
          } }
        { float* sq = P_ssq; for (int i = bx * (NWAVES * 64) + tid; i < 8 * M; i += G * NWAVES * 64) sq[M + i] = 0.f; }
        if (bx == 0) for (int i = tid; i < XCD_BAR_WORDS; i += NWAVES * 64) ((unsigned*)(P_ws + WS_BAR))[i] = 0u;
        for (int i = bx * (NWAVES * 64) + tid; i < 16 * 128; i += G * NWAVES * 64) {
            const int h = i >> 7, n = i & 127;
            int bucket = n;
            if (n >= 16) { const int lg = 16 + (int)(logf((float)n / 16.0f) / 2.0794415416798357f * 16.0f); bucket = lg < 31 ? lg : 31; }
            P_tabg[i] = P_rel_bias[bucket * 16 + h];
        }
    }
    grid.sync();
    volatile LAS unsigned* bst = (volatile LAS unsigned*)(lds + 131072 + 1024);
    if (tid < 2) bst[tid] = 0u;
    __syncthreads();
    XcdBarrier xbar = xcd_barrier_post((unsigned*)(P_ws + WS_BAR), bst);
#define GRID_BAR() xcd_barrier(xbar)

    for (int layer = 0; layer < 4; ++layer) {
        const float* ssq_in = P_ssq + (size_t)(2 * layer) * M;
        float* ssq_mid = P_ssq + (size_t)(2 * layer + 1) * M;
        float* ssq_out = P_ssq + (size_t)(2 * layer + 2) * M;
        const float* resid_in = layer == 0 ? P_x : P_out;
        if (layer < 2) {
            for (int rep = 0; rep < REP_QKV; ++rep) if (PH(1)) { pg8::Gemm g{P_HB, (const bf16*)(P_ws + WS_WA_QKV + layer * WA_STRIDE), M, 3 * D, D}; pg8::StaticOrder S; S.init(M, 3 * D, G, bx);
              pg8::EpiQKV E{P_Qb, P_Kb, P_VTb, ssq_in};
              pg8::gemm_phase<pg8::EpiQKV, pg8::StaticOrder, true, true>(lds, g, S, E); }
            GRID_BAR();
#ifdef NAIVE_SB
            if (PH(2)) sb_attn_naive(P_Qb, P_Kb, P_VTb, P_Ob, bx * 512 + tid, G * 512);
#else
            for (int rep = 0; rep < REP_SB; ++rep) if (PH(2)) sb_attn_phase(P_Qb, P_Kb, P_VTb, P_Ob, gw, NGW, lane);
#endif
            GRID_BAR();
            if (PH(3)) { pg8::Gemm g{P_Ob, (const bf16*)(P_ws + WS_WA_O + layer * WA_STRIDE), M, D, D}; pg8::StaticOrder S; S.init(M, D, G, bx);
              pg8::EpiResid E{resid_in, P_out, P_HB, nullptr, ssq_mid};
              pg8::gemm_phase<pg8::EpiResid, pg8::StaticOrder, true, true>(lds, g, S, E); }
            GRID_BAR();
        } else {
            const int j = layer - 2;
            if (PH(4)) { if (j == 0) { pg8::Gemm g{P_HB, (const bf16*)(P_ws + WS_WB_Q0), M, 1280, D}; pg8::StaticOrder S; S.init(M, 1280, G, bx);
              pg8::EpiQB<true> E{P_Qb, P_KSH, P_VTSH, P_b_bq, P_b_kv, ssq_in};
              pg8::gemm_phase<pg8::EpiQB<true>, pg8::StaticOrder, true, true>(lds, g, S, E); }
            else { pg8::Gemm g{P_HB, (const bf16*)(P_ws + WS_WB_Q1), M, D, D}; pg8::StaticOrder S; S.init(M, D, G, bx);
              pg8::EpiQB<false> E{P_Qb, P_KSH, P_VTSH, P_b_bq + D, P_b_kv, ssq_in};
              pg8::gemm_phase<pg8::EpiQB<false>, pg8::StaticOrder, true, true>(lds, g, S, E); } }
            { int t2 = tid; asm volatile("" : "+v"(t2)); LAS float* tab = (LAS float*)lds; const float* tg = P_tabg; for (int i = t2; i < 16 * 128; i += NWAVES * 64) tab[i] = tg[i]; }
            GRID_BAR();
#ifdef NAIVE_SWA
            if (PH(5)) swa_attn_naive(P_Qb, P_KSH, P_VTSH, P_Ob, P_b_sinks + j * 16, P_tabg, bx * 512 + tid, G * 512);
#else
            for (int rep = 0; rep < REP_SWA; ++rep) if (PH(5)) swa_attn_phase(P_Qb, P_KSH, P_VTSH, P_Ob, P_b_sinks + j * 16, (const LAS float*)lds, gw, NGW, lane);
#endif
            GRID_BAR();
            if (PH(3)) { pg8::Gemm g{P_Ob, (const bf16*)(P_ws + WS_WB_O + j * 2 * MiB), M, D, D}; pg8::StaticOrder S; S.init(M, D, G, bx);
              pg8::EpiResid E{resid_in, P_out, P_HB, P_b_bo + j * D, ssq_mid};
              pg8::gemm_phase<pg8::EpiResid, pg8::StaticOrder, true, true>(lds, g, S, E); }
            GRID_BAR();
        }
        for (int rep = 0; rep < REP_UP; ++rep) if (PH(6)) { pg8::Gemm g{P_HB, (const bf16*)(P_ws + WS_WUP + layer * WM_STRIDE), M, FF, D}; pg8::StaticOrder S; S.init(M, FF, G, bx);
          pg8::EpiUp E{P_U, ssq_mid};
          pg8::gemm_phase<pg8::EpiUp, pg8::StaticOrder, true, true>(lds, g, S, E); }
        for (int rep = 0; rep < EXTRA_SYNC; ++rep) GRID_BAR();
        GRID_BAR();
        if (PH(7)) { pg8::Gemm g{P_U, (const bf16*)(P_ws + WS_WDN + layer * WM_STRIDE), M, D, FF}; pg8::StaticOrder S; S.init(M, D, G, bx);
          pg8::EpiResid E{P_out, P_out, P_HB, nullptr, ssq_out};
          pg8::gemm_phase<pg8::EpiResid, pg8::StaticOrder, true, true>(lds, g, S, E); }
        GRID_BAR();
    }
    if (PH(8)) {
        int lane_f = tid & 63; asm volatile("" : "+v"(lane_f));
        const float* ssq_fin = P_ssq + (size_t)8 * M;
        f32x4 gv[4];
#pragma unroll
        for (int j = 0; j < 4; ++j) gv[j] = ((const f32x4*)P_final_norm)[lane_f + 64 * j];
        float* op = P_out;
        for (int m = gw; m < M; m += 2 * NGW) {
            const int m2 = m + NGW;
            f32x4* xr = (f32x4*)(op + (size_t)m * D) + lane_f; f32x4* xr2 = (f32x4*)(op + (size_t)m2 * D) + lane_f;
            const float rs = pg8::rstd_of(ssq_fin[m]), rs2 = pg8::rstd_of(ssq_fin[m2]);
            f32x4 va[4], vb[4];
#pragma unroll
            for (int j = 0; j < 4; ++j) { va[j] = xr[64 * j]; vb[j] = xr2[64 * j]; }
#pragma unroll
            for (int j = 0; j < 4; ++j) { xr[64 * j] = va[j] * rs * gv[j]; xr2[64 * j] = vb[j] * rs2 * gv[j]; }
        }
    }
}

extern "C" void kernel_launch(void* const* d_in, const int* in_sizes, int n_in, void* d_out, int out_size, void* d_ws, size_t ws_size, hipStream_t stream) {
    static int grid = 0;
    if (grid == 0) {
        if (n_in != 18 || out_size != M * D || ws_size < WS_END) { fprintf(stderr, "kernel_launch: unexpected shapes (n_in %d, out %d, ws %zu)\n", n_in, out_size, ws_size); grid = -1; return; }
        int dev = 0, cus = 0, per_cu = 0;
        hipGetDevice(&dev);
        hipDeviceGetAttribute(&cus, hipDeviceAttributeMultiprocessorCount, dev);
        if (hipFuncSetAttribute((const void*)yoco_fwd, hipFuncAttributeMaxDynamicSharedMemorySize, LDS_BYTES) != hipSuccess) { fprintf(stderr, "kernel_launch: hipFuncSetAttribute failed\n"); grid = -1; return; }
        if (hipOccupancyMaxActiveBlocksPerMultiprocessor(&per_cu, (const void*)yoco_fwd, NWAVES * 64, LDS_BYTES) != hipSuccess || per_cu < 1) { fprintf(stderr, "kernel_launch: occupancy query failed (%d)\n", per_cu); per_cu = 1; }
        (void)hipGetLastError();
        grid = cus * per_cu;
        fprintf(stderr, "kernel_launch: grid %d (cus %d x %d)\n", grid, cus, per_cu);
    }
    if (grid < 0) return;
    Args a{};
    for (int i = 0; i < 18; ++i) a.in[i] = (const float*)d_in[i];
    a.out = (float*)d_out; a.ws = (unsigned char*)d_ws;
    void* kargs[] = {&a};
    hipError_t e = hipLaunchCooperativeKernel((const void*)yoco_fwd, dim3(grid), dim3(NWAVES * 64), kargs, LDS_BYTES, stream);
    if (e != hipSuccess) fprintf(stderr, "kernel_launch: cooperative launch failed: %s (grid %d)\n", hipGetErrorString(e), grid);
}
```

```cpp
#include <hip/hip_runtime.h>
#include <hip/hip_cooperative_groups.h>
#include <cstdio>
#include <cstdint>
namespace cg = cooperative_groups;
namespace pg8 {
#define PG8_LAS __attribute__((address_space(3)))
typedef unsigned short bf16_t;
typedef short bf16x8 __attribute__((ext_vector_type(8)));
typedef float f32x4 __attribute__((ext_vector_type(4)));
typedef unsigned u32x4 __attribute__((ext_vector_type(4)));
constexpr int BM = 256, BK = 64, HALF = 128, HTB = HALF * BK * 2  , STAGE_BYTES = 8 * HTB, NXCD = 8, WGM = 8;

__host__ __device__ __forceinline__ int lds_byte(int r, int c) { const int st = (r >> 4) * 2 + (c >> 5), rr = r & 15, cc = c & 31, ob = rr * 64 + cc * 2; return st * 1024 + (ob ^ (((ob >> 9) & 1) << 5)); }
__host__ __device__ __forceinline__ void stage_rc(int b, int& R, int& C) { const int st = b / 1024, sb = b % 1024, swz = sb ^ (((sb >> 9) & 1) << 5); R = (st >> 1) * 16 + swz / 64; C = (st & 1) * 32 + (swz % 64) / 2; }
__host__ __device__ __forceinline__ int perm32(int rho) { const int n = rho >> 4, i = rho & 15; return 8 * (i >> 2) + 4 * n + (i & 3); }

struct Unit { int pm, pn; };
struct Gemm { const bf16_t* A; const bf16_t* Bt; int M, N, K; };

struct StaticOrder {
    int nM, nN, nwg, G, c;
    __host__ __device__ void init(int M, int N, int G_, int c_) { nM = M / BM; nN = N / BM; nwg = nM * nN; G = G_; c = c_; }
    __host__ __device__ bool next(int i, Unit& u) const {
        const long L = (long)i * G + c; if (L >= nwg) return false;
        int wgid = (int)L; { const int q = nwg / NXCD, r = nwg % NXCD, xcd = wgid % NXCD, off = wgid / NXCD; wgid = (xcd < r ? xcd * (q + 1) : r * (q + 1) + (xcd - r) * q) + off; }
        const int nig = WGM * nN, gid = wgid / nig, fm = gid * WGM, gsz = (nM - fm) < WGM ? (nM - fm) : WGM;
        u.pm = fm + ((wgid % nig) % gsz); u.pn = (wgid % nig) / gsz; return true;
    }
    __device__ __forceinline__ void a_ready(const Unit&) const {}
    __device__ __forceinline__ void done(const Unit&) const {}
};

__device__ __forceinline__ unsigned cvt_pk_bf16(float lo, float hi) { unsigned r; asm volatile("v_cvt_pk_bf16_f32 %0, %1, %2" : "=v"(r) : "v"(lo), "v"(hi)); return r; }
typedef float f32x2 __attribute__((ext_vector_type(2)));
typedef unsigned u32x2 __attribute__((ext_vector_type(2)));
constexpr float RMS_EPS = 1e-5f;
constexpr int DM = 1024, SEQ = 4096, FF = 4096;
typedef unsigned long long u64;
constexpr float SSQ_FIX = 1048576.0f;
__device__ __forceinline__ float rstd_of(u64 q) { return 1.0f / sqrtf((float)q * (1.0f / (SSQ_FIX * 1024.0f)) + RMS_EPS); }
__device__ __forceinline__ unsigned short bf1(float v) { return (unsigned short)(cvt_pk_bf16(v, 0.f) & 0xffffu); }

struct EpiQKV {
    static constexpr bool PERM = true, AFTER_DRAIN = false;
    bf16_t* Q; bf16_t* K; bf16_t* VT; const u64* ssq;
    __device__ __forceinline__ void operator()(const f32x4 (&acc)[2][2][4][2], const Unit& u, int wr, int wc, int fr, int fq) const {
        const int row0 = u.pm * BM + wr * 64 + fr;
        const int t = u.pn >> 2, col0 = (u.pn & 3) * BM + wc * 32 + 8 * fq;
        if (t < 2) {
#pragma unroll
            for (int ai = 0; ai < 2; ++ai)
#pragma unroll
                for (int m = 0; m < 4; ++m) { const int row = row0 + ai * HALF + m * 16; const float rs = rstd_of(ssq[row]);
                    bf16_t* rowp = t == 0 ? Q + (size_t)row * DM + col0 : K + ((size_t)((row >> 12) * 16 + (col0 >> 6)) * SEQ + (row & 4095)) * 64 + (col0 & 63);
                    const size_t bjstep = t == 0 ? (size_t)HALF : (size_t)2 * SEQ * 64;
#pragma unroll
                    for (int bj = 0; bj < 2; ++bj) { const f32x4 v0 = acc[ai][bj][m][0] * rs, v1 = acc[ai][bj][m][1] * rs; u32x4 w;
                        w.x = cvt_pk_bf16(v0[0], v0[1]); w.y = cvt_pk_bf16(v0[2], v0[3]); w.z = cvt_pk_bf16(v1[0], v1[1]); w.w = cvt_pk_bf16(v1[2], v1[3]);
                        *(u32x4*)(rowp + bj * bjstep) = w; } }
        } else {
#pragma unroll
            for (int ai = 0; ai < 2; ++ai)
#pragma unroll
                for (int m = 0; m < 4; ++m) { asm volatile("" ::: "memory"); const int row = row0 + ai * HALF + m * 16; const float rs = rstd_of(ssq[row]); const int b = row >> 12, s = row & 4095;
                    bf16_t* cp = VT + ((((size_t)(b * 16 + (col0 >> 6))) * 128 + (s >> 5)) * 64 + (col0 & 63)) * 32 + (s & 31);
#pragma unroll
                    for (int bj = 0; bj < 2; ++bj)
#pragma unroll
                        for (int n = 0; n < 2; ++n)
#pragma unroll
                            for (int j = 0; j < 4; ++j) cp[(size_t)bj * (2 * 128 * 64 * 32) + (4 * n + j) * 32] = bf1(acc[ai][bj][m][n][j] * rs); }
        }
    }
};

template <bool HAS_KV> struct EpiQB {
    static constexpr bool PERM = true, AFTER_DRAIN = false;
    bf16_t* Q; bf16_t* Ksh; bf16_t* VTsh; const float* bq; const float* bkv; const u64* ssq;
    __device__ __forceinline__ void operator()(const f32x4 (&acc)[2][2][4][2], const Unit& u, int wr, int wc, int fr, int fq) const {
        const int row0 = u.pm * BM + wr * 64 + fr;
        if (!HAS_KV || u.pn < 4) {
            const int col0 = u.pn * BM + wc * 32 + 8 * fq;
#pragma unroll
            for (int ai = 0; ai < 2; ++ai)
#pragma unroll
                for (int m = 0; m < 4; ++m) { const int row = row0 + ai * HALF + m * 16; const float rs = rstd_of(ssq[row]); bf16_t* rowp = Q + (size_t)row * DM + col0;
#pragma unroll
                    for (int bj = 0; bj < 2; ++bj) { const f32x4 b0 = *(const f32x4*)(bq + col0 + bj * HALF), b1 = *(const f32x4*)(bq + col0 + bj * HALF + 4);
                        const f32x4 v0 = acc[ai][bj][m][0] * rs + b0, v1 = acc[ai][bj][m][1] * rs + b1; u32x4 w;
                        w.x = cvt_pk_bf16(v0[0], v0[1]); w.y = cvt_pk_bf16(v0[2], v0[3]); w.z = cvt_pk_bf16(v1[0], v1[1]); w.w = cvt_pk_bf16(v1[2], v1[3]);
                        *(u32x4*)(rowp + bj * HALF) = w; }
                    asm volatile("" ::: "memory"); }
        } else {
            const int c0 = wc * 32 + 8 * fq;
#pragma unroll
            for (int ai = 0; ai < 2; ++ai)
#pragma unroll
                for (int m = 0; m < 4; ++m) { const int row = row0 + ai * HALF + m * 16; const float rs = rstd_of(ssq[row]); const int b = row >> 12, s = row & 4095;
                    { const f32x4 b0 = *(const f32x4*)(bkv + c0), b1 = *(const f32x4*)(bkv + c0 + 4);
                      const f32x4 v0 = acc[ai][0][m][0] * rs + b0, v1 = acc[ai][0][m][1] * rs + b1; u32x4 w;
                      w.x = cvt_pk_bf16(v0[0], v0[1]); w.y = cvt_pk_bf16(v0[2], v0[3]); w.z = cvt_pk_bf16(v1[0], v1[1]); w.w = cvt_pk_bf16(v1[2], v1[3]);
                      *(u32x4*)(Ksh + ((size_t)(b * 2 + (c0 >> 6)) * SEQ + s) * 64 + (c0 & 63)) = w; }
                    bf16_t* cp = VTsh + ((((size_t)(b * 2 + (c0 >> 6))) * 128 + (s >> 5)) * 64 + (c0 & 63)) * 32 + (s & 31);
#pragma unroll
                    for (int n = 0; n < 2; ++n) { const f32x4 bb = *(const f32x4*)(bkv + 128 + c0 + 4 * n);
#pragma unroll
                        for (int j = 0; j < 4; ++j) cp[(4 * n + j) * 32] = bf1(acc[ai][1][m][n][j] * rs + bb[j]); }
                    asm volatile("" ::: "memory"); }
        }
    }
};

struct EpiUp {
    static constexpr bool PERM = true, AFTER_DRAIN = false;
    bf16_t* U; const u64* ssq;
    __device__ __forceinline__ void operator()(const f32x4 (&acc)[2][2][4][2], const Unit& u, int wr, int wc, int fr, int fq) const {
        const int row0 = u.pm * BM + wr * 64 + fr, col0 = u.pn * BM + wc * 32 + 8 * fq;
#pragma unroll
        for (int ai = 0; ai < 2; ++ai)
#pragma unroll
            for (int m = 0; m < 4; ++m) { const int row = row0 + ai * HALF + m * 16; const float rs = rstd_of(ssq[row]); bf16_t* rowp = U + (size_t)row * FF + col0;
#pragma unroll
                for (int bj = 0; bj < 2; ++bj) { f32x4 v0 = acc[ai][bj][m][0] * rs, v1 = acc[ai][bj][m][1] * rs;
#pragma unroll
                    for (int j = 0; j < 4; ++j) { const float a = fmaxf(v0[j], 0.f), b = fmaxf(v1[j], 0.f); v0[j] = a * a; v1[j] = b * b; }
                    u32x4 w; w.x = cvt_pk_bf16(v0[0], v0[1]); w.y = cvt_pk_bf16(v0[2], v0[3]); w.z = cvt_pk_bf16(v1[0], v1[1]); w.w = cvt_pk_bf16(v1[2], v1[3]);
                    *(u32x4*)(rowp + bj * HALF) = w; } }
    }
};

template <bool BASE_F32> struct EpiResid {
    static constexpr bool PERM = false, AFTER_DRAIN = false;
    const float* basef; bf16_t* hb; const float* bias; u64* ssq_out;
    __device__ __forceinline__ void operator()(const f32x4 (&acc)[2][2][4][2], const Unit& u, int wr, int wc, int fr, int fq) const {
        const int row0 = u.pm * BM + wr * 64 + fr, col0 = u.pn * BM + wc * 32 + 4 * fq;
        f32x4 bv[2][2];
#pragma unroll
        for (int bj = 0; bj < 2; ++bj)
#pragma unroll
            for (int n = 0; n < 2; ++n) bv[bj][n] = bias ? *(const f32x4*)(bias + col0 + bj * HALF + n * 16) : (f32x4){0.f, 0.f, 0.f, 0.f};
#pragma unroll
        for (int ai = 0; ai < 2; ++ai)
#pragma unroll
            for (int m = 0; m < 4; ++m) { const int row = row0 + ai * HALF + m * 16; const size_t off = (size_t)row * DM + col0; float s = 0.f;
#pragma unroll
                for (int bj = 0; bj < 2; ++bj)
#pragma unroll
                    for (int n = 0; n < 2; ++n) { f32x4 bs;
                        if (BASE_F32) bs = *(const f32x4*)(basef + off + bj * HALF + n * 16);
                        else { const u32x2 b2 = *(const u32x2*)(hb + off + bj * HALF + n * 16);
                               bs[0] = __uint_as_float(b2.x << 16); bs[1] = __uint_as_float(b2.x & 0xffff0000u); bs[2] = __uint_as_float(b2.y << 16); bs[3] = __uint_as_float(b2.y & 0xffff0000u); }
                        const f32x4 v = bs + acc[ai][bj][m][n] + bv[bj][n];
                        u32x2 w; w.x = cvt_pk_bf16(v[0], v[1]); w.y = cvt_pk_bf16(v[2], v[3]);
                        *(u32x2*)(hb + off + bj * HALF + n * 16) = w; s += (v[0] * v[0] + v[1] * v[1]) + (v[2] * v[2] + v[3] * v[3]); }
                s += __shfl_xor(s, 16); s += __shfl_xor(s, 32);
                if (fq == 0) atomicAdd(ssq_out + row, (u64)(s * SSQ_FIX));
                asm volatile("" ::: "memory"); }
    }
};

template <class Epi, class Sched, bool ALIGN_EPI = false, bool SP2 = false>
__device__ __forceinline__ void gemm_phase(PG8_LAS unsigned char* lds, const Gemm g, const Sched& S, const Epi& E) {
    int tid_l = threadIdx.x; asm volatile("" : "+v"(tid_l));
    const int tid = tid_l, wid = __builtin_amdgcn_readfirstlane(tid >> 6), lane = tid & 63, wr = wid >> 2, wc = wid & 3, fr = lane & 15, fq = lane >> 4;
    const int K = g.K, nt = K / BK;
    unsigned voffA[2], voffB[2];
#pragma unroll
    for (int i = 0; i < 2; ++i) { int R, C; stage_rc(tid * 16 + i * 8192, R, C); const int Rb = Epi::PERM ? ((R & ~31) + perm32(R & 31)) : R;
        voffA[i] = (unsigned)(R * K + C) * 2u; voffB[i] = (unsigned)(Rb * K + C) * 2u; }
    const size_t kstep = (size_t)(BK * 2);
    const size_t hstep = (size_t)HALF * K * 2;
    const size_t tstep = 2 * hstep;
    const unsigned ldsw = (unsigned)wid * 1024u;
    const int aoff = lds_byte(wr * 64 + fr, fq * 8), boff = lds_byte(wc * 32 + fr, fq * 8);
#define PG8_SA(b, h) (((b) * 2 + (h)) * HTB)
#define PG8_SB(b, h) ((4 + (b) * 2 + (h)) * HTB)
#define PG8_STAGE(bufoff, gbase, voff) do { _Pragma("unroll") for (int _i = 0; _i < 2; ++_i) \
        __builtin_amdgcn_global_load_lds((const unsigned*)((const char*)(gbase) + (voff)[_i]), (PG8_LAS unsigned*)(lds + (bufoff) + ldsw + _i * 8192), 16, 0, 0); } while (0)
#define PG8_LDA(dst, b, h) do { _Pragma("unroll") for (int m = 0; m < 4; ++m) _Pragma("unroll") for (int k = 0; k < 2; ++k) dst[m][k] = *(const PG8_LAS bf16x8*)(lds + PG8_SA(b, h) + aoff + m * 2048 + k * 1024); } while (0)
#define PG8_LDB(dst, b, h) do { _Pragma("unroll") for (int n = 0; n < 2; ++n) _Pragma("unroll") for (int k = 0; k < 2; ++k) dst[n][k] = *(const PG8_LAS bf16x8*)(lds + PG8_SB(b, h) + boff + n * 2048 + k * 1024); } while (0)
#define PG8_MMA(ai, bj, At, Bt) do { __builtin_amdgcn_s_setprio(1); _Pragma("unroll") for (int m = 0; m < 4; ++m) _Pragma("unroll") for (int n = 0; n < 2; ++n) _Pragma("unroll") for (int k = 0; k < 2; ++k) \
        acc[ai][bj][m][n] = __builtin_amdgcn_mfma_f32_16x16x32_bf16(Bt[n][k], At[m][k], acc[ai][bj][m][n], 0, 0, 0); __builtin_amdgcn_s_setprio(0); } while (0)
#define PG8_WAIT_V(n) asm volatile("s_waitcnt vmcnt(" #n ")" ::: "memory")
#define PG8_WAIT_L(n) asm volatile("s_waitcnt lgkmcnt(" #n ")" ::: "memory")
#define PG8_BAR __builtin_amdgcn_s_barrier()
#define PG8_SCHED __builtin_amdgcn_sched_barrier(0)
    Unit cur, nxt; int ui = 0;
    if (!S.next(0, cur)) return;
    f32x4 acc[2][2][4][2];
#pragma unroll
    for (int a = 0; a < 2; ++a)
#pragma unroll
        for (int b = 0; b < 2; ++b)
#pragma unroll
            for (int m = 0; m < 4; ++m)
#pragma unroll
                for (int n = 0; n < 2; ++n) acc[a][b][m][n] = (f32x4){0.f, 0.f, 0.f, 0.f};
    bf16x8 At[4][2], B0[2][2], B1[2][2];
    const char* cA = (const char*)g.A + (size_t)cur.pm * tstep; const char* cB = (const char*)g.Bt + (size_t)cur.pn * tstep;
    S.a_ready(cur);
    if constexpr (SP2) {
        PG8_STAGE(PG8_SB(0, 0), cB, voffB); PG8_STAGE(PG8_SB(0, 1), cB + hstep, voffB); PG8_STAGE(PG8_SA(0, 0), cA, voffA); PG8_STAGE(PG8_SA(0, 1), cA + hstep, voffA);
        if (wr == 1) PG8_BAR;
        PG8_WAIT_V(2); PG8_BAR;
        PG8_STAGE(PG8_SB(1, 0), cB + kstep, voffB); PG8_STAGE(PG8_SA(1, 0), cA + kstep, voffA); PG8_STAGE(PG8_SB(1, 1), cB + hstep + kstep, voffB);
        PG8_WAIT_V(6); PG8_BAR;
    } else {
        PG8_STAGE(PG8_SB(0, 0), cB, voffB); PG8_STAGE(PG8_SA(0, 0), cA, voffA); PG8_STAGE(PG8_SB(0, 1), cB + hstep, voffB); PG8_STAGE(PG8_SA(0, 1), cA + hstep, voffA);
        if (wr == 1) PG8_BAR;
        PG8_WAIT_V(4); PG8_BAR;
        PG8_STAGE(PG8_SB(1, 0), cB + kstep, voffB); PG8_STAGE(PG8_SA(1, 0), cA + kstep, voffA); PG8_STAGE(PG8_SB(1, 1), cB + hstep + kstep, voffB);
        PG8_WAIT_V(6); PG8_BAR;
    }
    for (;;) {
        const bool has_next = S.next(ui + 1, nxt);
        const char* nA = has_next ? (const char*)g.A + (size_t)nxt.pm * tstep : cA; const char* nB = has_next ? (const char*)g.Bt + (size_t)nxt.pn * tstep : cB;
        for (int t = 0; t < nt; t += 2) {
            const bool last = (t == nt - 2);
            const char* a1 = cA + (size_t)(t + 1) * kstep;
            const char* a2 = last ? nA : cA + (size_t)(t + 2) * kstep; const char* b2 = last ? nB : cB + (size_t)(t + 2) * kstep;
            const char* a3 = a2 + kstep; const char* b3 = b2 + kstep;
            if (last && has_next) S.a_ready(nxt);
            if constexpr (SP2) {
            PG8_LDB(B0, 0, 0); PG8_LDB(B1, 0, 1); PG8_SCHED; PG8_LDA(At, 0, 0); PG8_STAGE(PG8_SA(1, 1), a1 + hstep, voffA);
            PG8_WAIT_V(8); PG8_WAIT_L(0); PG8_BAR; PG8_MMA(0, 0, At, B0); PG8_MMA(0, 1, At, B1); PG8_BAR; PG8_SCHED;
            PG8_LDA(At, 0, 1); PG8_STAGE(PG8_SB(0, 0), b2, voffB); PG8_STAGE(PG8_SB(0, 1), b2 + hstep, voffB); PG8_STAGE(PG8_SA(0, 0), a2, voffA);
            PG8_WAIT_V(8); PG8_WAIT_L(0); PG8_BAR; PG8_MMA(1, 0, At, B0); PG8_MMA(1, 1, At, B1); PG8_BAR; PG8_SCHED;
            PG8_LDB(B0, 1, 0); PG8_LDB(B1, 1, 1); PG8_SCHED; PG8_LDA(At, 1, 0); PG8_STAGE(PG8_SA(0, 1), a2 + hstep, voffA);
            PG8_WAIT_V(8); PG8_WAIT_L(0); PG8_BAR; PG8_MMA(0, 0, At, B0); PG8_MMA(0, 1, At, B1); PG8_BAR; PG8_SCHED;
            PG8_LDA(At, 1, 1); PG8_STAGE(PG8_SB(1, 0), b3, voffB); PG8_STAGE(PG8_SB(1, 1), b3 + hstep, voffB); PG8_STAGE(PG8_SA(1, 0), a3, voffA);
            PG8_WAIT_V(8); PG8_WAIT_L(0); PG8_BAR; PG8_MMA(1, 0, At, B0); PG8_MMA(1, 1, At, B1); PG8_BAR; PG8_SCHED;
            } else {
            PG8_LDB(B0, 0, 0); PG8_SCHED; PG8_LDA(At, 0, 0); PG8_STAGE(PG8_SA(1, 1), a1 + hstep, voffA);
            PG8_WAIT_L(8); PG8_BAR; PG8_WAIT_L(0); PG8_MMA(0, 0, At, B0); PG8_BAR; PG8_SCHED;
            PG8_LDB(B1, 0, 1); PG8_STAGE(PG8_SB(0, 0), b2, voffB);
            PG8_BAR; PG8_WAIT_L(0); PG8_MMA(0, 1, At, B1); PG8_BAR;
            PG8_LDA(At, 0, 1); PG8_STAGE(PG8_SA(0, 0), a2, voffA);
            PG8_BAR; PG8_WAIT_L(0); PG8_MMA(1, 0, At, B0); PG8_BAR; PG8_SCHED;
            PG8_STAGE(PG8_SB(0, 1), b2 + hstep, voffB);
            PG8_WAIT_V(6); PG8_BAR; PG8_MMA(1, 1, At, B1); PG8_BAR;
            PG8_LDB(B0, 1, 0); PG8_SCHED; PG8_LDA(At, 1, 0); PG8_STAGE(PG8_SA(0, 1), a2 + hstep, voffA);
            PG8_WAIT_L(8); PG8_BAR; PG8_WAIT_L(0); PG8_MMA(0, 0, At, B0); PG8_BAR; PG8_SCHED;
            PG8_LDB(B1, 1, 1); PG8_STAGE(PG8_SB(1, 0), b3, voffB);
            PG8_BAR; PG8_WAIT_L(0); PG8_MMA(0, 1, At, B1); PG8_BAR;
            PG8_LDA(At, 1, 1); PG8_STAGE(PG8_SA(1, 0), a3, voffA);
            PG8_BAR; PG8_WAIT_L(0); PG8_MMA(1, 0, At, B0); PG8_BAR; PG8_SCHED;
            PG8_STAGE(PG8_SB(1, 1), b3 + hstep, voffB);
            PG8_WAIT_V(6); PG8_BAR; PG8_MMA(1, 1, At, B1); PG8_BAR;
            }
        }
        if constexpr (ALIGN_EPI) { if (wr == 0) PG8_BAR; }
        if constexpr (!Epi::AFTER_DRAIN) { E(acc, cur, wr, wc, fr, fq); S.done(cur); }
        if (!has_next) break;
#pragma unroll
        for (int a = 0; a < 2; ++a)
#pragma unroll
            for (int b = 0; b < 2; ++b)
#pragma unroll
                for (int m = 0; m < 4; ++m)
#pragma unroll
                    for (int n = 0; n < 2; ++n) acc[a][b][m][n] = (f32x4){0.f, 0.f, 0.f, 0.f};
        cur = nxt; cA = nA; cB = nB; ++ui;
        if constexpr (ALIGN_EPI) { if (wr == 1) PG8_BAR; }
    }
    PG8_WAIT_V(0);
    if constexpr (!ALIGN_EPI) { if (wr == 0) PG8_BAR; }
    PG8_BAR;
    if constexpr (Epi::AFTER_DRAIN) { E.fused(acc, cur, wr, wc, fr, fq, lds, wid, lane); S.done(cur); }
#undef PG8_SA
#undef PG8_SB
#undef PG8_STAGE
#undef PG8_LDA
#undef PG8_LDB
#undef PG8_MMA
#undef PG8_WAIT_V
#undef PG8_WAIT_L
#undef PG8_BAR
#undef PG8_SCHED
}
}

#define LAS __attribute__((address_space(3)))
typedef unsigned short bf16;
typedef unsigned v4u __attribute__((ext_vector_type(4)));
typedef unsigned v2u __attribute__((ext_vector_type(2)));
typedef float f32x4 __attribute__((ext_vector_type(4)));
typedef float f32x16 __attribute__((ext_vector_type(16)));
typedef short bf16x8 __attribute__((ext_vector_type(8)));
using pg8::cvt_pk_bf16;

constexpr int NWAVES = 8;
constexpr int BATCH = 8, SEQ = 4096, D = 1024, FF = 4096, M = BATCH * SEQ;
constexpr size_t MiB = 1u << 20;
constexpr size_t WS_SSQ = 428 * MiB;
constexpr size_t WS_BAR = 1280 * 1024;
constexpr size_t WS_TAB = 1536 * 1024;
constexpr size_t WS_WA_QKV = 2 * MiB, WS_WA_O = 8 * MiB, WA_STRIDE = 8 * MiB;
constexpr size_t WS_WB_Q0 = 18 * MiB;
constexpr size_t WS_WB_Q1 = 21 * MiB;
constexpr size_t WS_WB_O = 23 * MiB;
constexpr size_t WS_WUP = 27 * MiB, WS_WDN = 35 * MiB, WM_STRIDE = 16 * MiB;
constexpr size_t WS_HB = 92 * MiB;
constexpr size_t WS_KSH = 156 * MiB, WS_VTSH = 164 * MiB;
constexpr size_t WS_BIG = 172 * MiB;
constexpr size_t WS_END = 431 * MiB;
constexpr int LDS_BYTES = 147456;

__device__ __forceinline__ float wave_sum(float v) {
#pragma unroll
    for (int o = 1; o < 64; o <<= 1) v += __shfl_xor(v, o);
    return v;
}
typedef float f32x2_t __attribute__((ext_vector_type(2))); typedef __bf16 bf16x2_t __attribute__((ext_vector_type(2)));
__device__ __forceinline__ unsigned pk2(float lo, float hi) { f32x2_t v = {lo, hi}; bf16x2_t b = __builtin_convertvector(v, bf16x2_t); return __builtin_bit_cast(unsigned, b); }

__device__ __forceinline__ void transpose_item(const float* W, const float* gain, int K, int N, bf16* WT, int row_off, LAS float* scr, int item, int lane) {
    const int nblk = N / 32, kb = item / nblk, nb = item % nblk, k0 = 64 * kb, n0 = 32 * nb;
    const float* wp = W + (size_t)(k0 + (lane >> 5)) * N + n0 + (lane & 31);
    float v[32];
#pragma unroll
    for (int i = 0; i < 32; ++i) v[i] = wp[(size_t)(2 * i) * N];
    const int c = lane & 7;
    f32x4 g0 = {1.f, 1.f, 1.f, 1.f}, g1 = {1.f, 1.f, 1.f, 1.f};
    if (gain) { g0 = *(const f32x4*)(gain + k0 + 8 * c); g1 = *(const f32x4*)(gain + k0 + 8 * c + 4); }
#pragma unroll
    for (int i = 0; i < 32; ++i) scr[(2 * i + (lane >> 5)) * 33 + (lane & 31)] = v[i];
    asm volatile("s_waitcnt lgkmcnt(0)" ::: "memory");
#pragma unroll
    for (int j = 0; j < 4; ++j) { const int n = (lane >> 3) + 8 * j; const LAS float* s = scr + (8 * c) * 33 + n;
        v4u o; o.x = pk2(s[0 * 33] * g0.x, s[1 * 33] * g0.y); o.y = pk2(s[2 * 33] * g0.z, s[3 * 33] * g0.w); o.z = pk2(s[4 * 33] * g1.x, s[5 * 33] * g1.y); o.w = pk2(s[6 * 33] * g1.z, s[7 * 33] * g1.w);
        *(v4u*)(WT + (size_t)(row_off + n0 + n) * K + k0 + 8 * c) = o; }
    asm volatile("s_waitcnt lgkmcnt(0)" ::: "memory");
}

__device__ __forceinline__ int pi32(int m) { return (m & ~12) | ((m & 4) << 1) | ((m & 8) >> 1); }
#define MFMA32(a, b, c) __builtin_amdgcn_mfma_f32_32x32x16_bf16((a), (b), (c), 0, 0, 0)
constexpr float LOG2E = 1.4426950408889634f, LN2 = 0.6931471805599453f;

__device__ __forceinline__ void sb_attn_phase(const bf16* Q, const bf16* K, const bf16* VT, bf16* O, int gw, int ngw, int lane_in) {
    int lane = lane_in; asm volatile("" : "+v"(lane));
    const int ql = lane & 31, hi = lane >> 5, kperm = pi32(ql);
    for (int unit = gw; unit < BATCH * 16 * (SEQ / 32); unit += ngw) {
        const int qt = unit & 127, bh = unit >> 7, h = bh & 15, b = bh >> 4, q0 = qt * 32, t = q0 + ql;
        const size_t tok0 = (size_t)b * SEQ;
        const bf16* qp = Q + (tok0 + q0 + ql) * D + h * 64 + 8 * hi;
        bf16x8 qf[4];
#pragma unroll
        for (int kk = 0; kk < 4; ++kk) qf[kk] = *(const bf16x8*)(qp + 16 * kk);
        f32x16 o0, o1;
#pragma unroll
        for (int r = 0; r < 16; ++r) { o0[r] = 0.f; o1[r] = 0.f; }
        float carry = 0.f;
        const bf16* kbase = K + ((size_t)(b * 16 + h) * SEQ + kperm) * 64 + 8 * hi;
        const bf16* vbase = VT + (((size_t)(b * 16 + h) * 128) * 64 + ql) * 32 + 8 * hi;
        bf16x8 kf[4], vf[2][2], kn[4], vn[2][2];
        { const int k0 = q0;
#pragma unroll
          for (int kk = 0; kk < 4; ++kk) kf[kk] = *(const bf16x8*)(kbase + (size_t)k0 * 64 + 16 * kk);
#pragma unroll
          for (int dh = 0; dh < 2; ++dh)
#pragma unroll
              for (int a = 0; a < 2; ++a) vf[dh][a] = *(const bf16x8*)(vbase + (size_t)k0 * 64 + (32 * dh) * 32 + 16 * a); }
        for (int jb = qt; jb >= 0; --jb) {
            const int k0 = jb * 32;
            if (jb > 0) {
                const int k1 = k0 - 32;
#pragma unroll
                for (int kk = 0; kk < 4; ++kk) kn[kk] = *(const bf16x8*)(kbase + (size_t)k1 * 64 + 16 * kk);
#pragma unroll
                for (int dh = 0; dh < 2; ++dh)
#pragma unroll
                    for (int a = 0; a < 2; ++a) vn[dh][a] = *(const bf16x8*)(vbase + (size_t)k1 * 64 + (32 * dh) * 32 + 16 * a);
            }
            f32x16 p;
#pragma unroll
            for (int r = 0; r < 16; ++r) p[r] = 0.f;
#pragma unroll
            for (int kk = 0; kk < 4; ++kk) p = MFMA32(kf[kk], qf[kk], p);
            float L[2][8], ls[2][8], cs[2], pcs[2];
#pragma unroll
            for (int a = 0; a < 2; ++a) { float acc = 0.f;
#pragma unroll
                for (int i = 0; i < 8; ++i) {
                    const float z = p[8 * a + i] * (0.125f * LOG2E);
                    const bool valid = (k0 + 16 * a + 8 * hi + i) < t;
                    const float sp = __builtin_amdgcn_logf(1.0f + __builtin_amdgcn_exp2f(-fabsf(z)));
                    L[a][i] = valid ? -(fmaxf(z, 0.f) + sp) : 0.f;
                    ls[a][i] = valid ? (fminf(z, 0.f) - sp) : -1e30f;
                    acc += L[a][i]; }
                cs[a] = acc; }
#pragma unroll
            for (int a = 0; a < 2; ++a) pcs[a] = __shfl_xor(cs[a], 32);
            float run = carry;
            bf16x8 wf[2];
#pragma unroll
            for (int a = 1; a >= 0; --a) {
                float r_ = run + (hi == 0 ? pcs[a] : 0.f);
                float w[8];
#pragma unroll
                for (int i = 7; i >= 0; --i) { w[i] = __builtin_amdgcn_exp2f(ls[a][i] + r_); r_ += L[a][i]; }
                v4u pk; pk.x = pk2(w[0], w[1]); pk.y = pk2(w[2], w[3]); pk.z = pk2(w[4], w[5]); pk.w = pk2(w[6], w[7]);
                wf[a] = __builtin_bit_cast(bf16x8, pk);
                run += cs[a] + pcs[a]; }
            carry = run;
#pragma unroll
            for (int a = 0; a < 2; ++a) { o0 = MFMA32(vf[0][a], wf[a], o0); o1 = MFMA32(vf[1][a], wf[a], o1); }
            if (__all(carry < -104.0f * LOG2E)) break;
#pragma unroll
            for (int kk = 0; kk < 4; ++kk) kf[kk] = kn[kk];
#pragma unroll
            for (int dh = 0; dh < 2; ++dh)
#pragma unroll
                for (int a = 0; a < 2; ++a) vf[dh][a] = vn[dh][a];
        }
        bf16* op = O + (tok0 + q0 + ql) * D + h * 64 + 4 * hi;
#pragma unroll
        for (int g = 0; g < 4; ++g) {
            v2u a; a.x = pk2(o0[4 * g], o0[4 * g + 1]); a.y = pk2(o0[4 * g + 2], o0[4 * g + 3]); *(v2u*)(op + 8 * g) = a;
            v2u c; c.x = pk2(o1[4 * g], o1[4 * g + 1]); c.y = pk2(o1[4 * g + 2], o1[4 * g + 3]); *(v2u*)(op + 32 + 8 * g) = c; }
    }
}

__device__ __forceinline__ void swa_attn_phase(const bf16* Q, const bf16* Ksh, const bf16* VTsh, bf16* O, const float* sinks, const LAS float* tab, int gw, int ngw, int lane_in) {
    int lane = lane_in; asm volatile("" : "+v"(lane));
    const int ql = lane & 31, hi = lane >> 5, kperm = pi32(ql);
    for (int unit = gw; unit < BATCH * 16 * (SEQ / 32); unit += ngw) {
        const int qt = unit & 127, bh = unit >> 7, qh = bh & 15, b = bh >> 4, kvh = qh >> 3, q0 = qt * 32, t = q0 + ql;
        const size_t tok0 = (size_t)b * SEQ;
        const bf16* qp = Q + (tok0 + q0 + ql) * D + qh * 64 + 8 * hi;
        bf16x8 qf[4];
#pragma unroll
        for (int kk = 0; kk < 4; ++kk) qf[kk] = *(const bf16x8*)(qp + 16 * kk);
        const float sink = sinks[qh];
        const LAS float* tb = tab + qh * 128;
        bf16x8 kf[5][4], vf[5][2][2];
        const bf16* vbase = VTsh + (((size_t)(b * 2 + kvh) * 128) * 64 + ql) * 32 + 8 * hi;
#pragma unroll
        for (int j = 0; j < 5; ++j) {
            const int k0 = q0 - 128 + 32 * j;
            if (k0 >= 0) {
                const bf16* kp = Ksh + ((size_t)(b * 2 + kvh) * SEQ + k0 + kperm) * 64 + 8 * hi;
#pragma unroll
                for (int kk = 0; kk < 4; ++kk) kf[j][kk] = *(const bf16x8*)(kp + 16 * kk);
            } else {
#pragma unroll
                for (int kk = 0; kk < 4; ++kk) kf[j][kk] = (bf16x8){0, 0, 0, 0, 0, 0, 0, 0};
            }
        }
        f32x16 p[5];
        float mx = sink;
#pragma unroll
        for (int j = 0; j < 5; ++j) {
#pragma unroll
            for (int r = 0; r < 16; ++r) p[j][r] = 0.f;
#pragma unroll
            for (int kk = 0; kk < 4; ++kk) p[j] = MFMA32(kf[j][kk], qf[kk], p[j]);
        }
        __builtin_amdgcn_sched_barrier(0);
#pragma unroll
        for (int j = 0; j < 5; ++j) {
            const int k0 = q0 - 128 + 32 * j;
            if (k0 >= 0) {
#pragma unroll
                for (int a = 0; a < 2; ++a) { vf[j][a][0] = *(const bf16x8*)(vbase + (size_t)k0 * 64 + 16 * a); vf[j][a][1] = *(const bf16x8*)(vbase + (size_t)k0 * 64 + 32 * 32 + 16 * a); }
            } else {
#pragma unroll
                for (int a = 0; a < 2; ++a) { vf[j][a][0] = (bf16x8){0, 0, 0, 0, 0, 0, 0, 0}; vf[j][a][1] = (bf16x8){0, 0, 0, 0, 0, 0, 0, 0}; }
            }
        }
#pragma unroll
        for (int j = 0; j < 5; ++j) {
            const int k0 = q0 - 128 + 32 * j;
#pragma unroll
            for (int r = 0; r < 16; ++r) {
                const int dist = t - (k0 + 16 * (r >> 3) + 8 * hi + (r & 7));
                const bool valid = (k0 >= 0) && dist >= 0 && dist < 128;
                const float s = valid ? (p[j][r] * 0.125f + tb[dist & 127]) : -1e30f;
                p[j][r] = s; mx = fmaxf(mx, s); }
        }
        mx = fmaxf(mx, __shfl_xor(mx, 32));
        float sum = 0.f;
        bf16x8 pf[5][2];
#pragma unroll
        for (int j = 0; j < 5; ++j) {
            float e[16];
#pragma unroll
            for (int r = 0; r < 16; ++r) { e[r] = __builtin_amdgcn_exp2f((p[j][r] - mx) * LOG2E); sum += e[r]; }
#pragma unroll
            for (int a = 0; a < 2; ++a) { v4u pk; pk.x = pk2(e[8 * a], e[8 * a + 1]); pk.y = pk2(e[8 * a + 2], e[8 * a + 3]); pk.z = pk2(e[8 * a + 4], e[8 * a + 5]); pk.w = pk2(e[8 * a + 6], e[8 * a + 7]);
                pf[j][a] = __builtin_bit_cast(bf16x8, pk); }
        }
        sum += __shfl_xor(sum, 32);
        sum += __builtin_amdgcn_exp2f((sink - mx) * LOG2E);
        const float inv = 1.0f / sum;
        f32x16 o0, o1;
#pragma unroll
        for (int r = 0; r < 16; ++r) { o0[r] = 0.f; o1[r] = 0.f; }
#pragma unroll
        for (int j = 0; j < 5; ++j)
#pragma unroll
            for (int a = 0; a < 2; ++a) { o0 = MFMA32(vf[j][a][0], pf[j][a], o0); o1 = MFMA32(vf[j][a][1], pf[j][a], o1); }
        bf16* op = O + (tok0 + q0 + ql) * D + qh * 64 + 4 * hi;
#pragma unroll
        for (int g = 0; g < 4; ++g) {
            v2u a; a.x = pk2(o0[4 * g] * inv, o0[4 * g + 1] * inv); a.y = pk2(o0[4 * g + 2] * inv, o0[4 * g + 3] * inv); *(v2u*)(op + 8 * g) = a;
            v2u c; c.x = pk2(o1[4 * g] * inv, o1[4 * g + 1] * inv); c.y = pk2(o1[4 * g + 2] * inv, o1[4 * g + 3] * inv); *(v2u*)(op + 32 + 8 * g) = c; }
    }
}


__device__ __forceinline__ float bf2f(bf16 v) { return __uint_as_float((unsigned)v << 16); }
__device__ __forceinline__ void sb_attn_naive(const bf16* Q, const bf16* K, const bf16* VT, bf16* O, int gtid_in, int gthreads) {
    int gtid = gtid_in; asm volatile("" : "+v"(gtid));
    for (int idx = gtid; idx < BATCH * 16 * SEQ; idx += gthreads) {
        const int t = idx & 4095, bh = idx >> 12, h = bh & 15, b = bh >> 4;
        const size_t tok0 = (size_t)b * SEQ;
        float o[64]; const bf16* q = Q + (tok0 + t) * D + h * 64;
#pragma unroll
        for (int d = 0; d < 64; ++d) o[d] = 0.f;
        float carry = 0.f;
        for (int s = t - 1; s >= 0; --s) {
            float z = 0.f;
#pragma unroll
            for (int d = 0; d < 64; ++d) z += bf2f(q[d]) * bf2f(K[(tok0 + s) * D + h * 64 + d]);
            z *= 0.125f;
            const float sp = __builtin_amdgcn_logf(1.0f + __builtin_amdgcn_exp2f(-fabsf(z) * 1.4426950408889634f)) * 0.6931471805599453f;
            const float w = __builtin_amdgcn_exp2f((fminf(z, 0.f) - sp + carry) * 1.4426950408889634f);
            carry += -(fmaxf(z, 0.f) + sp);
#pragma unroll
            for (int d = 0; d < 64; ++d) o[d] += w * bf2f(VT[((size_t)(b * D + h * 64 + d)) * SEQ + s]);
            if (carry < -104.f) break;
        }
#pragma unroll
        for (int d = 0; d < 64; ++d) O[(tok0 + t) * D + h * 64 + d] = pg8::bf1(o[d]);
    }
}
__device__ __forceinline__ void swa_attn_naive(const bf16* Q, const bf16* Ksh, const bf16* VTsh, bf16* O, const float* sinks, const float* tabg, int gtid_in, int gthreads) {
    int gtid = gtid_in; asm volatile("" : "+v"(gtid));
    for (int idx = gtid; idx < BATCH * 16 * SEQ; idx += gthreads) {
        const int t = idx & 4095, bh = idx >> 12, qh = bh & 15, b = bh >> 4, kvh = qh >> 3;
        const size_t tok0 = (size_t)b * SEQ;
        float o[64]; const bf16* q = Q + (tok0 + t) * D + qh * 64;
#pragma unroll
        for (int d = 0; d < 64; ++d) o[d] = 0.f;
        const float sink = sinks[qh];
        float mx = sink, sum = 0.f;
        const int s_lo = t - 127 > 0 ? t - 127 : 0;
        for (int s = s_lo; s <= t; ++s) {
            float z = 0.f;
#pragma unroll
            for (int d = 0; d < 64; ++d) z += bf2f(q[d]) * bf2f(Ksh[(tok0 + s) * 128 + kvh * 64 + d]);
            z = z * 0.125f + tabg[qh * 128 + (t - s)];
            const float nm = fmaxf(mx, z), sc = __builtin_amdgcn_exp2f((mx - nm) * 1.4426950408889634f), e = __builtin_amdgcn_exp2f((z - nm) * 1.4426950408889634f);
            sum = sum * sc + e; mx = nm;
#pragma unroll
            for (int d = 0; d < 64; ++d) o[d] = o[d] * sc + e * bf2f(VTsh[((size_t)(b * 128 + kvh * 64 + d)) * SEQ + s]);
        }
        sum += __builtin_amdgcn_exp2f((sink - mx) * 1.4426950408889634f);
        const float inv = 1.0f / sum;
#pragma unroll
        for (int d = 0; d < 64; ++d) O[(tok0 + t) * D + qh * 64 + d] = pg8::bf1(o[d] * inv);
    }
}
#define XB_TMO      128
#define XB_XCNT(j)  (256  + 64 * (j))
#define XB_XSUB(j)  (1280 + 64 * (j))
#define XB_XGEN(j)  (2304 + 64 * (j))
#define XB_TOP      3328
#define XB_TOPGEN   3392
#define XCD_BAR_WORDS 3456
#define XB_SPIN_CAP (1u << 18)

__device__ __forceinline__ unsigned xb_ld(unsigned* p)              { return __hip_atomic_load(p, __ATOMIC_RELAXED, __HIP_MEMORY_SCOPE_AGENT); }
__device__ __forceinline__ unsigned xb_add(unsigned* p, unsigned v) { return __hip_atomic_fetch_add(p, v, __ATOMIC_RELAXED, __HIP_MEMORY_SCOPE_AGENT); }
__device__ __forceinline__ unsigned xb_xcc_id() { return (unsigned)__builtin_amdgcn_s_getreg((3 << 11) | 20) & 0xFu; }
#define XB_SPIN(cond, bar) do { unsigned _sp = 0; while (cond) { __builtin_amdgcn_s_sleep(1); \
    if ((++_sp & 255u) == 0u) { if (xb_ld(&(bar)[XB_TMO])) break; if (_sp > XB_SPIN_CAP) { atomicAdd(&(bar)[XB_TMO], 1u); break; } } } } while (0)

struct XcdBarrier {
    unsigned* bar; unsigned x;
    volatile LAS unsigned* st;
};

__device__ __forceinline__ XcdBarrier xcd_barrier_post(unsigned* bar, volatile LAS unsigned* st) {
    XcdBarrier b; b.bar = bar; b.x = xb_xcc_id(); b.st = st;
    if (threadIdx.x == 0) (void)xb_add(&bar[XB_XCNT(b.x)], 1u);
    return b;
}
__device__ __forceinline__ void xcd_barrier_complete(unsigned* bar, unsigned x, unsigned& nloc, unsigned& nx) {
    const unsigned G = gridDim.x * gridDim.y * gridDim.z;
    unsigned sum, cnt, mine, sp = 0u;
    for (;;) {
        sum = 0u; cnt = 0u; mine = 0u;
#pragma unroll
        for (unsigned j = 0; j < 16; ++j) { const unsigned c = xb_ld(&bar[XB_XCNT(j)]); sum += c; cnt += (c > 0u) ? 1u : 0u; mine = (j == x) ? c : mine; }
        if (sum == G) break;
        __builtin_amdgcn_s_sleep(1);
        if ((++sp & 255u) == 0u) { if (xb_ld(&bar[XB_TMO])) break; if (sp > XB_SPIN_CAP) { atomicAdd(&bar[XB_TMO], 1u); break; } }
    }
    nloc = mine > 0u ? mine : 1u; nx = cnt > 0u ? cnt : 1u;
}

__device__ __forceinline__ void xcd_barrier(const XcdBarrier& b) {
    asm volatile("s_waitcnt vmcnt(0)" ::: "memory");
    __syncthreads();
    if (threadIdx.x == 0) {
        unsigned* bar = b.bar;
        __builtin_amdgcn_s_waitcnt(0);
        unsigned nloc = b.st[0], nx = b.st[1];
        if (nloc == 0u) { xcd_barrier_complete(bar, b.x, nloc, nx); b.st[0] = nloc; b.st[1] = nx; }
        const unsigned old = xb_add(&bar[XB_XSUB(b.x)], 1u);
        const unsigned gen = old / nloc;
        if (old + 1u == (gen + 1u) * nloc) {
            __builtin_amdgcn_fence(__ATOMIC_RELEASE, "agent");
            asm volatile("s_waitcnt vmcnt(0)" ::: "memory");
            const unsigned og = xb_add(&bar[XB_TOP], 1u);
            const unsigned tg = og / nx;
            if (og + 1u == (tg + 1u) * nx) xb_add(&bar[XB_TOPGEN], 1u);
            else XB_SPIN(xb_ld(&bar[XB_TOPGEN]) == tg, bar);
            __builtin_amdgcn_fence(__ATOMIC_ACQUIRE, "agent");
            xb_add(&bar[XB_XGEN(b.x)], 1u);
            asm volatile("s_waitcnt vmcnt(0)" ::: "memory");
        } else {
            XB_SPIN(xb_ld(&bar[XB_XGEN(b.x)]) == gen, bar);
            __builtin_amdgcn_fence(__ATOMIC_ACQUIRE, "agent");
            asm volatile("s_waitcnt vmcnt(0)" ::: "memory");
        }
    }
    __syncthreads();
}

#ifndef REP_PRO
#define REP_PRO 1
#endif
#ifndef REP_QKV
#define REP_QKV 1
#endif
#ifndef REP_SB
#define REP_SB 1
#endif
#ifndef REP_SWA
#define REP_SWA 1
#endif
#ifndef REP_UP
#define REP_UP 1
#endif
#ifndef EXTRA_SYNC
#define EXTRA_SYNC 0
#endif
#ifndef ONLY
#define ONLY -1
#endif
#define PH(n) (ONLY < 0 || ONLY == (n))
struct Args { const float* in[18]; float* out; unsigned char* ws; };

__global__ void __launch_bounds__(NWAVES * 64, 2) yoco_fwd(Args args) {
    extern __shared__ __attribute__((aligned(16))) unsigned char lds_raw[];
    cg::grid_group grid = cg::this_grid();
    LAS unsigned char* lds = (LAS unsigned char*)lds_raw;
    const int tid = threadIdx.x, lane = tid & 63, wave = __builtin_amdgcn_readfirstlane(tid >> 6);
    const int G = gridDim.x, bx = blockIdx.x;
    const int vcu = (G % 8 == 0) ? (bx % 8) * (G / 8) + bx / 8 : bx;
    const int gw = vcu * NWAVES + wave, NGW = G * NWAVES;
    volatile LAS unsigned long long* slots = (volatile LAS unsigned long long*)(lds + 131072 + 2048);
    if (tid == 0) {
#pragma unroll
        for (int i = 0; i < 18; ++i) slots[i] = (unsigned long long)args.in[i];
        slots[18] = (unsigned long long)args.out; slots[19] = (unsigned long long)args.ws;
    }
    __syncthreads();
#define GP(i) ((const float*)(((unsigned long long)(unsigned)__builtin_amdgcn_readfirstlane((unsigned)(slots[i] >> 32)) << 32) | (unsigned long long)(unsigned)__builtin_amdgcn_readfirstlane((unsigned)slots[i])))
#define P_x GP(0)
#define P_a_norm GP(1)
#define P_a_wqkv GP(2)
#define P_a_wo GP(3)
#define P_kv_norm GP(4)
#define P_w_kv GP(5)
#define P_b_kv GP(6)
#define P_b_norm GP(7)
#define P_b_wq GP(8)
#define P_b_bq GP(9)
#define P_b_sinks GP(10)
#define P_b_wo GP(11)
#define P_b_bo GP(12)
#define P_rel_bias GP(13)
#define P_mlp_norm GP(14)
#define P_mlp_up GP(15)
#define P_mlp_down GP(16)
#define P_final_norm GP(17)
#define P_out ((float*)GP(18))
#define P_ws ((unsigned char*)GP(19))
#define P_ssq ((pg8::u64*)(P_ws + WS_SSQ))
#define P_tabg ((float*)(P_ws + WS_TAB))
#define P_HB ((bf16*)(P_ws + WS_HB))
#define P_KSH ((bf16*)(P_ws + WS_KSH))
#define P_VTSH ((bf16*)(P_ws + WS_VTSH))
#define P_U ((bf16*)(P_ws + WS_BIG))
#define P_Qb ((bf16*)(P_ws + WS_BIG))
#define P_Kb ((bf16*)(P_ws + WS_BIG + 64 * MiB))
#define P_VTb ((bf16*)(P_ws + WS_BIG + 128 * MiB))
#define P_Ob ((bf16*)(P_ws + WS_BIG + 192 * MiB))

    for (int rep = 0; rep < REP_PRO; ++rep) if (PH(0)) {
        LAS float* scr = (LAS float*)(lds + wave * 16384);
        constexpr int I_QKV = (D / 64) * (3 * D / 32), I_DD = (D / 64) * (D / 32), I_KV = (D / 64) * (256 / 32), I_UP = (D / 64) * (FF / 32), I_DN = (FF / 64) * (D / 32);
        constexpr int NITEMS = 2 * (I_QKV + I_DD) + (I_DD + I_KV) + I_DD + 2 * I_DD + 4 * (I_UP + I_DN);
        for (int it = gw; it < NITEMS; it += NGW) {
            int r = it; bool done = false;
#pragma unroll
            for (int l = 0; l < 2; ++l) {
                if (!done && r < I_QKV) { transpose_item(P_a_wqkv + (size_t)l * D * 3 * D, P_a_norm + l * D, D, 3 * D, (bf16*)(P_ws + WS_WA_QKV + l * WA_STRIDE), 0, scr, r, lane); done = true; } if (!done) r -= I_QKV;
                if (!done && r < I_DD) { transpose_item(P_a_wo + (size_t)l * D * D, nullptr, D, D, (bf16*)(P_ws + WS_WA_O + l * WA_STRIDE), 0, scr, r, lane); done = true; } if (!done) r -= I_DD;
            }
            if (!done && r < I_DD) { transpose_item(P_b_wq, P_b_norm, D, D, (bf16*)(P_ws + WS_WB_Q0), 0, scr, r, lane); done = true; } if (!done) r -= I_DD;
            if (!done && r < I_KV) { transpose_item(P_w_kv, P_kv_norm, D, 256, (bf16*)(P_ws + WS_WB_Q0), 1024, scr, r, lane); done = true; } if (!done) r -= I_KV;
            if (!done && r < I_DD) { transpose_item(P_b_wq + (size_t)D * D, P_b_norm + D, D, D, (bf16*)(P_ws + WS_WB_Q1), 0, scr, r, lane); done = true; } if (!done) r -= I_DD;
#pragma unroll
            for (int j = 0; j < 2; ++j) { if (!done && r < I_DD) { transpose_item(P_b_wo + (size_t)j * D * D, nullptr, D, D, (bf16*)(P_ws + WS_WB_O + j * 2 * MiB), 0, scr, r, lane); done = true; } if (!done) r -= I_DD; }
#pragma unroll
            for (int l = 0; l < 4; ++l) {
                if (!done && r < I_UP) { transpose_item(P_mlp_up + (size_t)l * D * FF, P_mlp_norm + l * D, D, FF, (bf16*)(P_ws + WS_WUP + l * WM_STRIDE), 0, scr, r, lane); done = true; } if (!done) r -= I_UP;
                if (!done && r < I_DN) { transpose_item(P_mlp_down + (size_t)l * FF * D, nullptr, FF, D, (bf16*)(P_ws + WS_WDN + l * WM_STRIDE), 0, scr, r, lane); done = true; } if (!done) r -= I_DN;
            }
        }
        { const float* xp = P_x; bf16* hbp = P_HB; pg8::u64* sq = P_ssq;
          for (int m = gw; m < M; m += 2 * NGW) {
            const int m2 = m + NGW;
            const f32x4* xr = (const f32x4*)(xp + (size_t)m * D) + lane; const f32x4* xr2 = (const f32x4*)(xp + (size_t)m2 * D) + lane;
            f32x4 va[4], vb[4];
#pragma unroll
            for (int j = 0; j < 4; ++j) { va[j] = xr[64 * j]; vb[j] = xr2[64 * j]; }
            unsigned long long* o8 = (unsigned long long*)(hbp + (size_t)m * D) + lane; unsigned long long* o82 = (unsigned long long*)(hbp + (size_t)m2 * D) + lane;
            float s = 0.f, s2 = 0.f;
#pragma unroll
            for (int j = 0; j < 4; ++j) { const f32x4 v = va[j], w = vb[j];
                s += (v.x * v.x + v.y * v.y) + (v.z * v.z + v.w * v.w); s2 += (w.x * w.x + w.y * w.y) + (w.z * w.z + w.w * w.w);
                o8[64 * j] = (unsigned long long)pk2(v.x, v.y) | ((unsigned long long)pk2(v.z, v.w) << 32);
                o82[64 * j] = (unsigned long long)pk2(w.x, w.y) | ((unsigned long long)pk2(w.z, w.w) << 32); }
            s = wave_sum(s); s2 = wave_sum(s2);
            if (lane == 0) { sq[m] = (pg8::u64)(s * pg8::SSQ_FIX); sq[m2] = (pg8::u64)(s2 * pg8::SSQ_FIX); }
          } }
        { pg8::u64* sq = P_ssq; for (int i = bx * (NWAVES * 64) + tid; i < 8 * M; i += G * NWAVES * 64) sq[M + i] = 0ull; }
        if (bx == 0) for (int i = tid; i < XCD_BAR_WORDS; i += NWAVES * 64) ((unsigned*)(P_ws + WS_BAR))[i] = 0u;
        for (int i = bx * (NWAVES * 64) + tid; i < 16 * 128; i += G * NWAVES * 64) {
            const int h = i >> 7, n = i & 127;
            int bucket = n;
            if (n >= 16) { const int lg = 16 + (int)(logf((float)n / 16.0f) / 2.0794415416798357f * 16.0f); bucket = lg < 31 ? lg : 31; }
            P_tabg[i] = P_rel_bias[bucket * 16 + h];
        }
    }
    grid.sync();
    volatile LAS unsigned* bst = (volatile LAS unsigned*)(lds + 131072 + 1024);
    if (tid < 2) bst[tid] = 0u;
    __syncthreads();
    XcdBarrier xbar = xcd_barrier_post((unsigned*)(P_ws + WS_BAR), bst);
#define GRID_BAR() xcd_barrier(xbar)

    for (int layer = 0; layer < 4; ++layer) {
        const pg8::u64* ssq_in = P_ssq + (size_t)(2 * layer) * M;
        pg8::u64* ssq_mid = P_ssq + (size_t)(2 * layer + 1) * M;
        pg8::u64* ssq_out = P_ssq + (size_t)(2 * layer + 2) * M;
        if (layer < 2) {
            for (int rep = 0; rep < REP_QKV; ++rep) if (PH(1)) { pg8::Gemm g{P_HB, (const bf16*)(P_ws + WS_WA_QKV + layer * WA_STRIDE), M, 3 * D, D}; pg8::StaticOrder S; S.init(M, 3 * D, G, bx);
              pg8::EpiQKV E{P_Qb, P_Kb, P_VTb, ssq_in};
              pg8::gemm_phase<pg8::EpiQKV, pg8::StaticOrder, true, true>(lds, g, S, E); }
            GRID_BAR();
#ifdef NAIVE_SB
            if (PH(2)) sb_attn_naive(P_Qb, P_Kb, P_VTb, P_Ob, bx * 512 + tid, G * 512);
#else
            for (int rep = 0; rep < REP_SB; ++rep) if (PH(2)) sb_attn_phase(P_Qb, P_Kb, P_VTb, P_Ob, gw, NGW, lane);
#endif
            GRID_BAR();
            if (PH(3)) { pg8::Gemm g{P_Ob, (const bf16*)(P_ws + WS_WA_O + layer * WA_STRIDE), M, D, D}; pg8::StaticOrder S; S.init(M, D, G, bx);
              if (layer == 0) { pg8::EpiResid<true> E{P_x, P_HB, nullptr, ssq_mid}; pg8::gemm_phase<pg8::EpiResid<true>, pg8::StaticOrder, true, true>(lds, g, S, E); }
              else { pg8::EpiResid<false> E{nullptr, P_HB, nullptr, ssq_mid}; pg8::gemm_phase<pg8::EpiResid<false>, pg8::StaticOrder, true, true>(lds, g, S, E); } }
            GRID_BAR();
        } else {
            const int j = layer - 2;
            if (PH(4)) { if (j == 0) { pg8::Gemm g{P_HB, (const bf16*)(P_ws + WS_WB_Q0), M, 1280, D}; pg8::StaticOrder S; S.init(M, 1280, G, bx);
              pg8::EpiQB<true> E{P_Qb, P_KSH, P_VTSH, P_b_bq, P_b_kv, ssq_in};
              pg8::gemm_phase<pg8::EpiQB<true>, pg8::StaticOrder, true, true>(lds, g, S, E); }
            else { pg8::Gemm g{P_HB, (const bf16*)(P_ws + WS_WB_Q1), M, D, D}; pg8::StaticOrder S; S.init(M, D, G, bx);
              pg8::EpiQB<false> E{P_Qb, P_KSH, P_VTSH, P_b_bq + D, P_b_kv, ssq_in};
              pg8::gemm_phase<pg8::EpiQB<false>, pg8::StaticOrder, true, true>(lds, g, S, E); } }
            { int t2 = tid; asm volatile("" : "+v"(t2)); LAS float* tab = (LAS float*)lds; const float* tg = P_tabg; for (int i = t2; i < 16 * 128; i += NWAVES * 64) tab[i] = tg[i]; }
            GRID_BAR();
#ifdef NAIVE_SWA
            if (PH(5)) swa_attn_naive(P_Qb, P_KSH, P_VTSH, P_Ob, P_b_sinks + j * 16, P_tabg, bx * 512 + tid, G * 512);
#else
            for (int rep = 0; rep < REP_SWA; ++rep) if (PH(5)) swa_attn_phase(P_Qb, P_KSH, P_VTSH, P_Ob, P_b_sinks + j * 16, (const LAS float*)lds, gw, NGW, lane);
#endif
            GRID_BAR();
            if (PH(3)) { pg8::Gemm g{P_Ob, (const bf16*)(P_ws + WS_WB_O + j * 2 * MiB), M, D, D}; pg8::StaticOrder S; S.init(M, D, G, bx);
              pg8::EpiResid<false> E{nullptr, P_HB, P_b_bo + j * D, ssq_mid};
              pg8::gemm_phase<pg8::EpiResid<false>, pg8::StaticOrder, true, true>(lds, g, S, E); }
            GRID_BAR();
        }
        for (int rep = 0; rep < REP_UP; ++rep) if (PH(6)) { pg8::Gemm g{P_HB, (const bf16*)(P_ws + WS_WUP + layer * WM_STRIDE), M, FF, D}; pg8::StaticOrder S; S.init(M, FF, G, bx);
          pg8::EpiUp E{P_U, ssq_mid};
          pg8::gemm_phase<pg8::EpiUp, pg8::StaticOrder, true, true>(lds, g, S, E); }
        for (int rep = 0; rep < EXTRA_SYNC; ++rep) GRID_BAR();
        GRID_BAR();
        if (PH(7)) { pg8::Gemm g{P_U, (const bf16*)(P_ws + WS_WDN + layer * WM_STRIDE), M, D, FF}; pg8::StaticOrder S; S.init(M, D, G, bx);
          pg8::EpiResid<false> E{nullptr, P_HB, nullptr, ssq_out};
          pg8::gemm_phase<pg8::EpiResid<false>, pg8::StaticOrder, true, true>(lds, g, S, E); }
        GRID_BAR();
    }
    if (PH(8)) {
        int lane_f = tid & 63; asm volatile("" : "+v"(lane_f));
        const pg8::u64* ssq_fin = P_ssq + (size_t)8 * M;
        f32x4 gv[4];
#pragma unroll
        for (int j = 0; j < 4; ++j) gv[j] = ((const f32x4*)P_final_norm)[lane_f + 64 * j];
        float* op = P_out; const bf16* hp = P_HB;
        for (int m = gw; m < M; m += 2 * NGW) {
            const int m2 = m + NGW;
            const v2u* hr = (const v2u*)(hp + (size_t)m * D) + lane_f; const v2u* hr2 = (const v2u*)(hp + (size_t)m2 * D) + lane_f;
            f32x4* xr = (f32x4*)(op + (size_t)m * D) + lane_f; f32x4* xr2 = (f32x4*)(op + (size_t)m2 * D) + lane_f;
            const float rs = pg8::rstd_of(ssq_fin[m]), rs2 = pg8::rstd_of(ssq_fin[m2]);
            v2u ha[4], hb2[4];
#pragma unroll
            for (int j = 0; j < 4; ++j) { ha[j] = hr[64 * j]; hb2[j] = hr2[64 * j]; }
#pragma unroll
            for (int j = 0; j < 4; ++j) {
                f32x4 a, c;
                a[0] = __uint_as_float(ha[j].x << 16); a[1] = __uint_as_float(ha[j].x & 0xffff0000u); a[2] = __uint_as_float(ha[j].y << 16); a[3] = __uint_as_float(ha[j].y & 0xffff0000u);
                c[0] = __uint_as_float(hb2[j].x << 16); c[1] = __uint_as_float(hb2[j].x & 0xffff0000u); c[2] = __uint_as_float(hb2[j].y << 16); c[3] = __uint_as_float(hb2[j].y & 0xffff0000u);
                xr[64 * j] = a * rs * gv[j]; xr2[64 * j] = c * rs2 * gv[j]; }
        }
    }
}

extern "C" void kernel_launch(void* const* d_in, const int* in_sizes, int n_in, void* d_out, int out_size, void* d_ws, size_t ws_size, hipStream_t stream) {
    static int grid = 0;
    if (grid == 0) {
        if (n_in != 18 || out_size != M * D || ws_size < WS_END) { fprintf(stderr, "kernel_launch: unexpected shapes (n_in %d, out %d, ws %zu)\n", n_in, out_size, ws_size); grid = -1; return; }
        int dev = 0, cus = 0, per_cu = 0;
        hipGetDevice(&dev);
        hipDeviceGetAttribute(&cus, hipDeviceAttributeMultiprocessorCount, dev);
        if (hipFuncSetAttribute((const void*)yoco_fwd, hipFuncAttributeMaxDynamicSharedMemorySize, LDS_BYTES) != hipSuccess) { fprintf(stderr, "kernel_launch: hipFuncSetAttribute failed\n"); grid = -1; return; }
        if (hipOccupancyMaxActiveBlocksPerMultiprocessor(&per_cu, (const void*)yoco_fwd, NWAVES * 64, LDS_BYTES) != hipSuccess || per_cu < 1) { fprintf(stderr, "kernel_launch: occupancy query failed (%d)\n", per_cu); per_cu = 1; }
        (void)hipGetLastError();
        grid = cus * per_cu;
        fprintf(stderr, "kernel_launch: grid %d (cus %d x %d)\n", grid, cus, per_cu);
    }
    if (grid < 0) return;
    Args a{};
    for (int i = 0; i < 18; ++i) a.in[i] = (const float*)d_in[i];
    a.out = (float*)d_out; a.ws = (unsigned char*)d_ws;
    void* kargs[] = {&a};
    hipError_t e = hipLaunchCooperativeKernel((const void*)yoco_fwd, dim3(grid), dim3(NWAVES * 64), kargs, LDS_BYTES, stream);
    if (e != hipSuccess) fprintf(stderr, "kernel_launch: cooperative launch failed: %s (grid %d)\n", hipGetErrorString(e), grid);
}
```
